# Optimizing an MI355X kernel written in HIP

```python
import math, functools
import jax, jax.numpy as jnp
from jax import lax
import numpy as np

D_MODEL = 1024
BATCH = 8
SEQ = 2048
DEPTH = 2
DEC_BATCH = 32
DEC_SEQ = 1
PAST_LEN = 16384
PAGE_SIZE = 128

CONV_W = 4
D_RNN = 1280
RG_BLOCK = 128
RG_BLOCKS = D_RNN // RG_BLOCK
RG_C = 8.0
GDN_HEADS = 8
GDN_DK = 128
GDN_DV = 128
GDN_KW = GDN_HEADS * GDN_DK
GDN_VW = GDN_HEADS * GDN_DV
GDN_CONV_C = 2 * GDN_KW + GDN_VW
GDN_CHUNK = 64
MLA_HEADS = 8
Q_LORA = 384
KV_LORA = 256
QK_NOPE = 64
QK_ROPE = 32
V_HEAD = 128
MLA_VW = MLA_HEADS * V_HEAD
MLA_SCALE = (QK_NOPE + QK_ROPE) ** -0.5
ROPE_BASE = 10000.0
Q_BLOCK = 128
D_FF = ((8 * D_MODEL // 3 + 255) // 256) * 256
N_BRANCH = 3
IN_SIZES = (D_RNN, D_RNN, GDN_CONV_C, GDN_VW, GDN_HEADS, GDN_HEADS, Q_LORA, KV_LORA + QK_ROPE, N_BRANCH * D_MODEL)
N_IN = sum(IN_SIZES)
EPS = 1e-6

kernel_name = 'hybrid_rglru_gdn_mla_adaln_step'


def rmsnorm(x, g):
    xf = x.astype(jnp.float32)
    y = xf * lax.rsqrt(jnp.mean(xf * xf, axis=-1, keepdims=True) + EPS)
    return (y * g.astype(jnp.float32)).astype(x.dtype)


def l2norm(x):
    xf = x.astype(jnp.float32)
    return xf * lax.rsqrt(jnp.sum(xf * xf, axis=-1, keepdims=True) + EPS)


def causal_conv(u, buf, w):
    T = u.shape[1]
    up = jnp.concatenate([buf.astype(u.dtype), u], axis=1)
    y = up[:, 0:T] * w[0]
    for j in range(1, CONV_W):
        y = y + up[:, j:j + T] * w[j]
    return y, up[:, T:]


def linear_recurrence(a, b, h0):
    def combine(left, right):
        al, bl = left
        ar, br = right
        return ar * al, ar * bl + br
    a_cum, h = lax.associative_scan(combine, (a, b), axis=1)
    return h + a_cum * h0[:, None, :]


def rglru_branch(u_x, u_y, buf, h0, conv_w, conv_b, wa, ba, wx, bx, lam):
    xc, new_buf = causal_conv(u_x, buf, conv_w)
    xc = xc + conv_b
    B, T, _ = xc.shape
    xb = xc.reshape(B, T, RG_BLOCKS, RG_BLOCK)
    r = jax.nn.sigmoid(jnp.einsum('btnj,njk->btnk', xb, wa).reshape(B, T, D_RNN) + ba)
    i = jax.nn.sigmoid(jnp.einsum('btnj,njk->btnk', xb, wx).reshape(B, T, D_RNN) + bx)
    log_a = -RG_C * r.astype(jnp.float32) * jax.nn.softplus(-lam.astype(jnp.float32))
    a = jnp.exp(log_a)
    b = jnp.sqrt(-jnp.expm1(2.0 * log_a)) * (i * xc).astype(jnp.float32)
    h = linear_recurrence(a, b, h0.astype(jnp.float32))
    out = h.astype(u_x.dtype) * jax.nn.gelu(u_y)
    return out, new_buf, h[:, -1]


def gated_delta_chunked(q, k, v, g, beta, S0):
    B, T, H, _ = q.shape
    C = GDN_CHUNK
    n = -(-T // C)
    pad = n * C - T
    f32 = jnp.float32

    def prep4(t):
        t = jnp.pad(t.astype(f32), ((0, 0), (0, pad), (0, 0), (0, 0)))
        return t.reshape(B, n, C, H, t.shape[-1]).transpose(1, 0, 3, 2, 4)

    def prep3(t):
        t = jnp.pad(t.astype(f32), ((0, 0), (0, pad), (0, 0)))
        return t.reshape(B, n, C, H).transpose(1, 0, 3, 2)

    tri_strict = jnp.tril(jnp.ones((C, C), bool), -1)
    tri_incl = jnp.tril(jnp.ones((C, C), bool))
    eye = jnp.eye(C, dtype=f32)

    def step(S, inp):
        qc, kc, vc, gc, bc = inp
        gcum = jnp.cumsum(gc, axis=-1)
        diff = gcum[..., :, None] - gcum[..., None, :]
        dec_strict = jnp.exp(jnp.where(tri_strict, diff, -jnp.inf))
        dec_incl = jnp.exp(jnp.where(tri_incl, diff, -jnp.inf))
        L = bc[..., :, None] * jnp.einsum('bhid,bhjd->bhij', kc, kc) * dec_strict
        rhs = bc[..., None] * (vc - jnp.exp(gcum)[..., None] * jnp.einsum('bhid,bhde->bhie', kc, S))
        U = lax.linalg.triangular_solve(eye + L, rhs, left_side=True, lower=True)
        qk = jnp.einsum('bhid,bhjd->bhij', qc, kc) * dec_incl
        o = jnp.exp(gcum)[..., None] * jnp.einsum('bhid,bhde->bhie', qc, S) + jnp.einsum('bhij,bhje->bhie', qk, U)
        g_last = gcum[..., -1]
        k_dec = kc * jnp.exp(g_last[..., None] - gcum)[..., None]
        S_new = jnp.exp(g_last)[..., None, None] * S + jnp.einsum('bhjd,bhje->bhde', k_dec, U)
        return S_new, o

    S, o = lax.scan(step, S0.astype(f32), (prep4(q), prep4(k), prep4(v), prep3(g), prep3(beta)))
    o = o.transpose(1, 0, 3, 2, 4).reshape(B, n * C, H, -1)[:, :T]
    return o, S


def gdn_branch(u_qkv, u_z, u_a, u_b, buf, S0, conv_w, A_log, dt_bias, norm_g):
    qkv, new_buf = causal_conv(u_qkv, buf, conv_w)
    qkv = jax.nn.silu(qkv)
    B, T, _ = qkv.shape
    q, k, v = jnp.split(qkv, [GDN_KW, 2 * GDN_KW], axis=-1)
    q = l2norm(q.reshape(B, T, GDN_HEADS, GDN_DK)) * (GDN_DK ** -0.5)
    k = l2norm(k.reshape(B, T, GDN_HEADS, GDN_DK))
    v = v.reshape(B, T, GDN_HEADS, GDN_DV)
    beta = jax.nn.sigmoid(u_b.astype(jnp.float32))
    g = -jnp.exp(A_log.astype(jnp.float32)) * jax.nn.softplus(u_a.astype(jnp.float32) + dt_bias.astype(jnp.float32))
    o, S = gated_delta_chunked(q, k, v, g, beta, S0)
    o = rmsnorm(o.astype(u_z.dtype), norm_g) * jax.nn.silu(u_z.reshape(B, T, GDN_HEADS, GDN_DV))
    return o.reshape(B, T, GDN_VW), new_buf, S


def rope_cos_sin(T, pos0):
    inv = ROPE_BASE ** (-jnp.arange(0, QK_ROPE, 2, dtype=jnp.float32) / QK_ROPE)
    ang = (jnp.arange(T, dtype=jnp.float32) + pos0)[:, None] * inv[None, :]
    return jnp.cos(ang), jnp.sin(ang)


def apply_rope(x, cos, sin):
    x1, x2 = jnp.split(x.astype(jnp.float32), 2, axis=-1)
    return jnp.concatenate([x1 * cos - x2 * sin, x2 * cos + x1 * sin], axis=-1).astype(x.dtype)


def mla_prompt_attention(q_nope, q_rope, c_kv, k_rope, w_ukv):
    B, S, H, _ = q_nope.shape
    kv = jnp.einsum('bsc,cf->bsf', c_kv, w_ukv).reshape(B, S, H, QK_NOPE + V_HEAD)
    k_nope, v = kv[..., :QK_NOPE], kv[..., QK_NOPE:]
    nb = S // Q_BLOCK
    qn = q_nope.reshape(B, nb, Q_BLOCK, H, QK_NOPE).transpose(1, 0, 2, 3, 4)
    qr = q_rope.reshape(B, nb, Q_BLOCK, H, QK_ROPE).transpose(1, 0, 2, 3, 4)
    key_pos = jnp.arange(S)

    def block(args):
        qn_b, qr_b, start = args
        s = (jnp.einsum('bqhd,bkhd->bhqk', qn_b, k_nope)
             + jnp.einsum('bqhr,bkr->bhqk', qr_b, k_rope)).astype(jnp.float32) * MLA_SCALE
        qpos = start + jnp.arange(Q_BLOCK)
        s = jnp.where(key_pos[None, :] <= qpos[:, None], s, -jnp.inf)
        p = jax.nn.softmax(s, axis=-1).astype(v.dtype)
        return jnp.einsum('bhqk,bkhe->bqhe', p, v)

    o = lax.map(block, (qn, qr, jnp.arange(nb) * Q_BLOCK))
    return o.transpose(1, 0, 2, 3, 4).reshape(B, S, H * V_HEAD)


def mla_sample_attention(q_nope, q_rope, c_kv, k_rope, w_ukv, ckv_pool, krope_pool, page_table, layer):
    Bd, T, H, _ = q_nope.shape
    w = w_ukv.reshape(KV_LORA, H, QK_NOPE + V_HEAD)
    w_uk, w_uv = w[..., :QK_NOPE], w[..., QK_NOPE:]
    q_lat = jnp.einsum('bthd,chd->bthc', q_nope, w_uk)
    ckv_past = ckv_pool[layer, page_table].reshape(Bd, -1, KV_LORA)
    kr_past = krope_pool[layer, page_table].reshape(Bd, -1, QK_ROPE)
    P = ckv_past.shape[1]
    s_past = jnp.einsum('bthc,bpc->bthp', q_lat, ckv_past) + jnp.einsum('bthr,bpr->bthp', q_rope, kr_past)
    s_new = jnp.einsum('bthc,bsc->bths', q_lat, c_kv) + jnp.einsum('bthr,bsr->bths', q_rope, k_rope)
    causal = jnp.tril(jnp.ones((T, T), bool))
    s_new = jnp.where(causal[None, :, None, :], s_new, -jnp.inf)
    s = jnp.concatenate([s_past, s_new], axis=-1).astype(jnp.float32) * MLA_SCALE
    p = jax.nn.softmax(s, axis=-1).astype(c_kv.dtype)
    o_lat = jnp.einsum('bthp,bpc->bthc', p[..., :P], ckv_past) + jnp.einsum('bths,bsc->bthc', p[..., P:], c_kv)
    return jnp.einsum('bthc,che->bthe', o_lat, w_uv).reshape(Bd, T, H * V_HEAD)


def hybrid_layer(x, c, pos0, rg_buf, rg_h0, gdn_buf, gdn_S0, attend,
                 w_ada, b_ada, g_norm1, g_norm2, w_in,
                 rg_conv_w, rg_conv_b, rg_wa, rg_ba, rg_wx, rg_bx, rg_lambda,
                 gdn_conv_w, gdn_A_log, gdn_dt_bias, gdn_norm_g,
                 mla_q_norm_g, w_uq, mla_kv_norm_g, w_ukv,
                 w_rg_proj, w_gdn_proj, w_mla_proj, w_o, w_ffn_in, w_ffn_out):
    B, T, _ = x.shape
    mod = jnp.einsum('bd,df->bf', jax.nn.silu(c), w_ada) + b_ada
    sh1, sc1, gt1, sh2, sc2, gt2 = jnp.split(mod[:, None, :], 6, axis=-1)

    h = rmsnorm(x, g_norm1) * (1.0 + sc1) + sh1
    u = jnp.einsum('btd,df->btf', h, w_in)
    offs = np.cumsum(IN_SIZES)[:-1].tolist()
    u_rx, u_ry, u_qkv, u_z, u_a, u_b, u_mq, u_mkv, u_gate = jnp.split(u, offs, axis=-1)

    o_rg, rg_buf_new, rg_h = rglru_branch(u_rx, u_ry, rg_buf, rg_h0, rg_conv_w, rg_conv_b,
                                          rg_wa, rg_ba, rg_wx, rg_bx, rg_lambda)
    o_gdn, gdn_buf_new, gdn_S = gdn_branch(u_qkv, u_z, u_a, u_b, gdn_buf, gdn_S0,
                                           gdn_conv_w, gdn_A_log, gdn_dt_bias, gdn_norm_g)
    cos, sin = rope_cos_sin(T, pos0)
    cq = rmsnorm(u_mq, mla_q_norm_g)
    q = jnp.einsum('btc,cf->btf', cq, w_uq).reshape(B, T, MLA_HEADS, QK_NOPE + QK_ROPE)
    q_nope = q[..., :QK_NOPE]
    q_rope = apply_rope(q[..., QK_NOPE:], cos[:, None, :], sin[:, None, :])
    c_kv = rmsnorm(u_mkv[..., :KV_LORA], mla_kv_norm_g)
    k_rope = apply_rope(u_mkv[..., KV_LORA:], cos, sin)
    o_mla = attend(q_nope, q_rope, c_kv, k_rope, w_ukv)

    ga, gb, gc = jnp.split(u_gate, N_BRANCH, axis=-1)
    m = (jax.nn.sigmoid(ga) * jnp.einsum('btf,fd->btd', o_rg, w_rg_proj)
         + jax.nn.sigmoid(gb) * jnp.einsum('btf,fd->btd', o_gdn, w_gdn_proj)
         + jax.nn.sigmoid(gc) * jnp.einsum('btf,fd->btd', o_mla, w_mla_proj))
    x = x + gt1 * jnp.einsum('btd,de->bte', m, w_o)

    h2 = rmsnorm(x, g_norm2) * (1.0 + sc2) + sh2
    gate, up = jnp.split(jnp.einsum('btd,df->btf', h2, w_ffn_in), 2, axis=-1)
    x = x + gt2 * jnp.einsum('btf,fd->btd', jax.nn.silu(gate) * up, w_ffn_out)
    return x, (c_kv, k_rope, rg_buf_new, rg_h, gdn_buf_new, gdn_S)


def setup_inputs(seed: int = 0) -> dict:
    key = jax.random.key(seed)
    keys = iter(jax.random.split(key, 64))
    f32 = jnp.float32
    L = DEPTH

    def nrm(shape, scale):
        return jax.random.normal(next(keys), shape, f32) * scale

    def gain(shape):
        return 1.0 + nrm(shape, 0.02)

    n_pages = PAST_LEN // PAGE_SIZE
    n_pool = (DEC_BATCH * n_pages * 5) // 4
    perm = jax.random.permutation(next(keys), n_pool)
    page_table = perm[:DEC_BATCH * n_pages].reshape(DEC_BATCH, n_pages).astype(jnp.int32)

    u_lam = jax.random.uniform(next(keys), (L, D_RNN), f32, 0.9, 0.999)
    s_lam = u_lam ** (1.0 / RG_C)
    rg_lambda = jnp.log(s_lam) - jnp.log1p(-s_lam)
    A = jax.random.uniform(next(keys), (L, GDN_HEADS), f32, 1.0, 16.0)
    dt = jnp.exp(jax.random.uniform(next(keys), (L, GDN_HEADS), f32, math.log(1e-3), math.log(1e-1)))
    dt_bias = dt + jnp.log(-jnp.expm1(-dt))

    return {
        'x_prompt': nrm((BATCH, SEQ, D_MODEL), 1.0),
        'x_sample': nrm((DEC_BATCH, DEC_SEQ, D_MODEL), 1.0),
        'cache_ckv': nrm((L, n_pool, PAGE_SIZE, KV_LORA), 1.0),
        'cache_krope': nrm((L, n_pool, PAGE_SIZE, QK_ROPE), 1.0),
        'state_rg_conv': nrm((L, DEC_BATCH, CONV_W - 1, D_RNN), 1.0),
        'state_rg_h': nrm((L, DEC_BATCH, D_RNN), 1.0),
        'state_gdn_conv': nrm((L, DEC_BATCH, CONV_W - 1, GDN_CONV_C), 1.0),
        'state_gdn_S': nrm((L, DEC_BATCH, GDN_HEADS, GDN_DK, GDN_DV), 0.5),
        'page_table': page_table,
        'c_prompt': nrm((BATCH, D_MODEL), 1.0),
        'c_sample': nrm((DEC_BATCH, D_MODEL), 1.0),
        'w_ada': nrm((L, D_MODEL, 6 * D_MODEL), 0.5 * D_MODEL ** -0.5),
        'b_ada': nrm((L, 6 * D_MODEL), 0.02),
        'g_norm1': gain((L, D_MODEL)),
        'g_norm2': gain((L, D_MODEL)),
        'w_in': nrm((L, D_MODEL, N_IN), D_MODEL ** -0.5),
        'rg_conv_w': nrm((L, CONV_W, D_RNN), CONV_W ** -0.5),
        'rg_conv_b': nrm((L, D_RNN), 0.02),
        'rg_wa': nrm((L, RG_BLOCKS, RG_BLOCK, RG_BLOCK), RG_BLOCK ** -0.5),
        'rg_ba': nrm((L, D_RNN), 0.02),
        'rg_wx': nrm((L, RG_BLOCKS, RG_BLOCK, RG_BLOCK), RG_BLOCK ** -0.5),
        'rg_bx': nrm((L, D_RNN), 0.02),
        'rg_lambda': rg_lambda,
        'gdn_conv_w': nrm((L, CONV_W, GDN_CONV_C), CONV_W ** -0.5),
        'gdn_A_log': jnp.log(A),
        'gdn_dt_bias': dt_bias,
        'gdn_norm_g': gain((L, GDN_DV)),
        'mla_q_norm_g': gain((L, Q_LORA)),
        'w_uq': nrm((L, Q_LORA, MLA_HEADS * (QK_NOPE + QK_ROPE)), Q_LORA ** -0.5),
        'mla_kv_norm_g': gain((L, KV_LORA)),
        'w_ukv': nrm((L, KV_LORA, MLA_HEADS * (QK_NOPE + V_HEAD)), KV_LORA ** -0.5),
        'w_rg_proj': nrm((L, D_RNN, D_MODEL), D_RNN ** -0.5),
        'w_gdn_proj': nrm((L, GDN_VW, D_MODEL), GDN_VW ** -0.5),
        'w_mla_proj': nrm((L, MLA_VW, D_MODEL), MLA_VW ** -0.5),
        'w_o': nrm((L, D_MODEL, D_MODEL), D_MODEL ** -0.5),
        'w_ffn_in': nrm((L, D_MODEL, 2 * D_FF), D_MODEL ** -0.5),
        'w_ffn_out': nrm((L, D_FF, D_MODEL), D_FF ** -0.5),
        'g_final': gain((D_MODEL,)),
    }


def reference(x_prompt, x_sample, cache_ckv, cache_krope, state_rg_conv, state_rg_h, state_gdn_conv, state_gdn_S,
              page_table, c_prompt, c_sample,
              w_ada, b_ada, g_norm1, g_norm2, w_in,
              rg_conv_w, rg_conv_b, rg_wa, rg_ba, rg_wx, rg_bx, rg_lambda,
              gdn_conv_w, gdn_A_log, gdn_dt_bias, gdn_norm_g,
              mla_q_norm_g, w_uq, mla_kv_norm_g, w_ukv,
              w_rg_proj, w_gdn_proj, w_mla_proj, w_o, w_ffn_in, w_ffn_out, g_final):
    xp, xs = x_prompt, x_sample
    Bp = xp.shape[0]
    zb_rg = jnp.zeros((Bp, CONV_W - 1, D_RNN), xp.dtype)
    zh_rg = jnp.zeros((Bp, D_RNN), xp.dtype)
    zb_gdn = jnp.zeros((Bp, CONV_W - 1, GDN_CONV_C), xp.dtype)
    zS_gdn = jnp.zeros((Bp, GDN_HEADS, GDN_DK, GDN_DV), jnp.float32)
    outs_p = []
    outs_s = []
    for l in range(DEPTH):
        lp = (w_ada[l], b_ada[l], g_norm1[l], g_norm2[l], w_in[l],
              rg_conv_w[l], rg_conv_b[l], rg_wa[l], rg_ba[l], rg_wx[l], rg_bx[l], rg_lambda[l],
              gdn_conv_w[l], gdn_A_log[l], gdn_dt_bias[l], gdn_norm_g[l],
              mla_q_norm_g[l], w_uq[l], mla_kv_norm_g[l], w_ukv[l],
              w_rg_proj[l], w_gdn_proj[l], w_mla_proj[l], w_o[l], w_ffn_in[l], w_ffn_out[l])
        xp, st_p = hybrid_layer(xp, c_prompt, 0.0, zb_rg, zh_rg, zb_gdn, zS_gdn, mla_prompt_attention, *lp)
        sample_attend = functools.partial(mla_sample_attention, ckv_pool=cache_ckv, krope_pool=cache_krope,
                                          page_table=page_table, layer=l)
        xs, st_s = hybrid_layer(xs, c_sample, float(PAST_LEN), state_rg_conv[l], state_rg_h[l],
                                state_gdn_conv[l], state_gdn_S[l], sample_attend, *lp)
        outs_p.append(st_p)
        outs_s.append(st_s)
    y_prompt = rmsnorm(xp, g_final)
    y_sample = rmsnorm(xs, g_final)
    ckv_p = jnp.stack([o[0] for o in outs_p])
    krope_p = jnp.stack([o[1] for o in outs_p])
    rg_conv_p = jnp.stack([o[2] for o in outs_p])
    rg_h_p = jnp.stack([o[3] for o in outs_p])
    gdn_conv_p = jnp.stack([o[4] for o in outs_p])
    gdn_S_p = jnp.stack([o[5] for o in outs_p])
    ckv_s = jnp.stack([o[0] for o in outs_s])
    krope_s = jnp.stack([o[1] for o in outs_s])
    rg_conv_s = jnp.stack([o[2] for o in outs_s])
    rg_h_s = jnp.stack([o[3] for o in outs_s])
    gdn_conv_s = jnp.stack([o[4] for o in outs_s])
    gdn_S_s = jnp.stack([o[5] for o in outs_s])
    return (y_prompt, y_sample, ckv_p, krope_p, rg_conv_p, rg_h_p, gdn_conv_p, gdn_S_p,
            ckv_s, krope_s, rg_conv_s, rg_h_s, gdn_conv_s, gdn_S_s)
```

```cpp
#include <hip/hip_runtime.h>
#include <stdint.h>

#define XB_TMO      128
#define XB_XCNT(j)  (256  + 64 * (j))
#define XB_XSUB(j)  (1280 + 64 * (j))
#define XB_XGEN(j)  (2304 + 64 * (j))
#define XB_TOP      3328
#define XB_TOPGEN   3392
#define XCD_BAR_WORDS 3456
#define XB_SPIN_CAP (1u << 26)
#define LAS __attribute__((address_space(3)))

__device__ __forceinline__ unsigned xb_ld(unsigned* p)              { return __hip_atomic_load(p, __ATOMIC_RELAXED, __HIP_MEMORY_SCOPE_AGENT); }
__device__ __forceinline__ unsigned xb_add(unsigned* p, unsigned v) { return __hip_atomic_fetch_add(p, v, __ATOMIC_RELAXED, __HIP_MEMORY_SCOPE_AGENT); }
__device__ __forceinline__ unsigned xb_xcc_id() { return (unsigned)__builtin_amdgcn_s_getreg((3 << 11) | 20) & 0xFu; }
#define XB_SPIN(cond, bar) do { unsigned _sp = 0; while (cond) { __builtin_amdgcn_s_sleep(1); \
    if ((++_sp & 255u) == 0u) { if (xb_ld(&(bar)[XB_TMO])) break; if (_sp > XB_SPIN_CAP) { atomicAdd(&(bar)[XB_TMO], 1u); break; } } } } while (0)

struct XcdBarrier { unsigned* bar; unsigned x; volatile LAS unsigned* st; };

__device__ __forceinline__ XcdBarrier xcd_barrier_post(unsigned* bar, volatile LAS unsigned* st) {
    XcdBarrier b; b.bar = bar; b.x = xb_xcc_id(); b.st = st;
    if (threadIdx.x == 0) (void)xb_add(&bar[XB_XCNT(b.x)], 1u);
    return b;
}
__device__ __forceinline__ void xcd_barrier_complete(unsigned* bar, unsigned x, unsigned& nloc, unsigned& nx) {
    const unsigned G = gridDim.x * gridDim.y * gridDim.z;
    unsigned sum, cnt, mine, sp = 0u;
    for (;;) {
        sum = 0u; cnt = 0u; mine = 0u;
#pragma unroll
        for (unsigned j = 0; j < 16; ++j) { const unsigned c = xb_ld(&bar[XB_XCNT(j)]); sum += c; cnt += (c > 0u) ? 1u : 0u; mine = (j == x) ? c : mine; }
        if (sum == G) break;
        __builtin_amdgcn_s_sleep(1);
        if ((++sp & 255u) == 0u) { if (xb_ld(&bar[XB_TMO])) break; if (sp > XB_SPIN_CAP) { atomicAdd(&bar[XB_TMO], 1u); break; } }
    }
    nloc = mine > 0u ? mine : 1u; nx = cnt > 0u ? cnt : 1u;
}
__device__ __forceinline__ void xcd_barrier(const XcdBarrier& b) {
    asm volatile("s_waitcnt vmcnt(0)" ::: "memory");
    __syncthreads();
    if (threadIdx.x == 0) {
        unsigned* bar = b.bar;
        __builtin_amdgcn_s_waitcnt(0);
        unsigned nloc = b.st[0], nx = b.st[1];
        if (nloc == 0u) { xcd_barrier_complete(bar, b.x, nloc, nx); b.st[0] = nloc; b.st[1] = nx; }
        const unsigned old = xb_add(&bar[XB_XSUB(b.x)], 1u);
        const unsigned gen = old / nloc;
        if (old + 1u == (gen + 1u) * nloc) {
            __builtin_amdgcn_fence(__ATOMIC_RELEASE, "agent");
            asm volatile("s_waitcnt vmcnt(0)" ::: "memory");
            const unsigned og = xb_add(&bar[XB_TOP], 1u);
            const unsigned tg = og / nx;
            if (og + 1u == (tg + 1u) * nx) xb_add(&bar[XB_TOPGEN], 1u);
            else XB_SPIN(xb_ld(&bar[XB_TOPGEN]) == tg, bar);
            __builtin_amdgcn_fence(__ATOMIC_ACQUIRE, "agent");
            xb_add(&bar[XB_XGEN(b.x)], 1u);
            asm volatile("s_waitcnt vmcnt(0)" ::: "memory");
        } else {
            XB_SPIN(xb_ld(&bar[XB_XGEN(b.x)]) == gen, bar);
            __builtin_amdgcn_fence(__ATOMIC_ACQUIRE, "agent");
            asm volatile("s_waitcnt vmcnt(0)" ::: "memory");
        }
    }
    __syncthreads();
}

__device__ __forceinline__ void grid_sync(const XcdBarrier& b0) {
    XcdBarrier b = b0;
    unsigned long long pb = (unsigned long long)b.bar; unsigned x = b.x;
    asm volatile("" : "+s"(pb), "+s"(x));
    b.bar = (unsigned*)pb; b.x = x;
    xcd_barrier(b);
}

namespace K {
constexpr int D = 1024, BP = 8, SEQ = 2048, NP = BP * SEQ, BS = 32, R = NP + BS, DEPTH = 2, NC = BP + BS;
constexpr int PAST = 16384, PAGE = 128, NPAGES = PAST / PAGE, NPOOL = (BS * NPAGES * 5) / 4;
constexpr int DRNN = 1280, RGB = 128, RGN = 10;
constexpr int GH = 8, GDK = 128, GDV = 128, GKW = 1024, GVW = 1024, GC = 3072;
constexpr int MH = 8, QL = 384, KVL = 256, NOPE = 64, ROPE = 32, VH = 128, QKD = 96;
constexpr int DFF = 2816, NIN = 10416;
constexpr int U_RX = 0, U_RY = 1280, U_QKV = 2560, U_Z = 5632, U_A = 6656, U_B = 6664, U_MQ = 6672, U_MKV = 7056, U_GATE = 7344;
constexpr int CATW = 3328, CAT_RG = 0, CAT_GDN = 1280, CAT_MLA = 2304;
constexpr float EPS = 1e-6f;
constexpr size_t O_YP = 0, O_YS = O_YP + (size_t)NP * D, O_CKVP = O_YS + (size_t)BS * D, O_KRP = O_CKVP + (size_t)DEPTH * NP * KVL,
    O_RGCP = O_KRP + (size_t)DEPTH * NP * ROPE, O_RGHP = O_RGCP + (size_t)DEPTH * BP * 3 * DRNN, O_GCP = O_RGHP + (size_t)DEPTH * BP * DRNN,
    O_GSP = O_GCP + (size_t)DEPTH * BP * 3 * GC, O_CKVS = O_GSP + (size_t)DEPTH * BP * GH * GDK * GDV, O_KRS = O_CKVS + (size_t)DEPTH * BS * KVL,
    O_RGCS = O_KRS + (size_t)DEPTH * BS * ROPE, O_RGHS = O_RGCS + (size_t)DEPTH * BS * 3 * DRNN, O_GCS = O_RGHS + (size_t)DEPTH * BS * DRNN,
    O_GSS = O_GCS + (size_t)DEPTH * BS * 3 * GC, O_END = O_GSS + (size_t)DEPTH * BS * GH * GDK * GDV;
}

struct Params {
    const float* x_prompt; const float* x_sample; const float* cache_ckv; const float* cache_krope;
    const float* state_rg_conv; const float* state_rg_h; const float* state_gdn_conv; const float* state_gdn_S;
    const int* page_table; const float* c_prompt; const float* c_sample;
    const float* w_ada; const float* b_ada; const float* g_norm1; const float* g_norm2; const float* w_in;
    const float* rg_conv_w; const float* rg_conv_b; const float* rg_wa; const float* rg_ba; const float* rg_wx; const float* rg_bx; const float* rg_lambda;
    const float* gdn_conv_w; const float* gdn_A_log; const float* gdn_dt_bias; const float* gdn_norm_g;
    const float* mla_q_norm_g; const float* w_uq; const float* mla_kv_norm_g; const float* w_ukv;
    const float* w_rg_proj; const float* w_gdn_proj; const float* w_mla_proj; const float* w_o; const float* w_ffn_in; const float* w_ffn_out; const float* g_final;
    float* out; unsigned* bar;
    float* csilu; float* mod; float* X0; float* X1; float* X2; float* H; float* U; float* XC; float* GR; float* GI;
    float* QKVC; float* GB; float* OG; float* CQ; float* CKV; float* KR; float* Q; float* KV; float* CATf_unused; float* M_unused; float* ACT_unused; float* ROT;
    unsigned short* HA; unsigned short* CAT; unsigned short* Mb; unsigned short* ACT; unsigned short* R1; unsigned short* R2; unsigned short* R3;
    unsigned short* WIN; unsigned short* WPR; unsigned short* WO; unsigned short* WFI; unsigned short* WFO;
    unsigned short* WUQ; unsigned short* WUKV; unsigned short* WRG; unsigned short* AQ; unsigned short* AKV;
    unsigned short* WUQP; unsigned short* WK; unsigned short* WV; unsigned short* Qb; unsigned short* Kb; unsigned short* Vt;
    float* PART; float* QLG; float* SPL;
    unsigned short* URX; unsigned short* GY; unsigned short* UQKV; unsigned short* SZ; float* USM;
    unsigned short* QKb; float* G_UT; unsigned short* G_WT; unsigned short* G_QG; unsigned short* G_KDT; unsigned short* G_AQK; float* G_EGL;
};

#define DEVI __device__ __forceinline__
static_assert(sizeof(Params) <= 896, "Params copy must end before the wave table at LDS byte 960");
#define NOINL static __device__ __forceinline__
extern __shared__ __attribute__((aligned(16))) unsigned char dyn_lds[];
#define PRM (*(const LAS Params*)(dyn_lds + 64))
template <class T> DEVI T* uni(T* p) { const unsigned long long v = (unsigned long long)p;
    const unsigned lo = __builtin_amdgcn_readfirstlane((unsigned)v), hi = __builtin_amdgcn_readfirstlane((unsigned)(v >> 32));
    typedef __attribute__((address_space(1))) T GT; return (T*)(GT*)(((unsigned long long)hi << 32) | lo); }
DEVI void lds_barrier() { asm volatile("s_waitcnt lgkmcnt(0)" ::: "memory"); __builtin_amdgcn_s_barrier(); asm volatile("" ::: "memory"); }
#define LDS_DATA ((float*)(dyn_lds + 1024))
#define GEMM_LDS ((LAS unsigned char*)(dyn_lds + 1024))
DEVI int otid() {
    const unsigned key = (unsigned)__builtin_amdgcn_s_getreg((5 << 11) | 4) & 63u;
    int w = ((volatile LAS unsigned char*)(dyn_lds + 1024 - 64))[key];
    int ln; asm volatile("v_mbcnt_lo_u32_b32 %0, -1, 0\n\tv_mbcnt_hi_u32_b32 %0, -1, %0" : "=v"(ln));
    int t = (w << 6) | ln;
    asm volatile("" : "+v"(t)); return t; }
DEVI int obid() { int b = blockIdx.x; asm volatile("" : "+s"(b)); return b; }
DEVI int ogrid() { int g = gridDim.x; asm volatile("" : "+s"(g)); return g; }
DEVI float sigmoid_f(float x) { return 1.0f / (1.0f + expf(-x)); }
DEVI float silu_f(float x) { return x * sigmoid_f(x); }
DEVI float softplus_f(float x) { return fmaxf(x, 0.f) + log1pf(expf(-fabsf(x))); }
DEVI float gelu_tanh_f(float x) { return 0.5f * x * (1.0f + tanhf(0.7978845608028654f * (x + 0.044715f * x * x * x))); }
DEVI float shx(float v, int mask, int lane) { return __int_as_float(__builtin_amdgcn_ds_bpermute((lane ^ mask) << 2, __float_as_int(v))); }
template <int CTRL> DEVI float dpp_mov(float v) { return __int_as_float(__builtin_amdgcn_update_dpp(0, __float_as_int(v), CTRL, 0xF, 0xF, true)); }
DEVI float row16_max(float v) { v = fmaxf(v, dpp_mov<0xB1>(v)); v = fmaxf(v, dpp_mov<0x4E>(v)); v = fmaxf(v, dpp_mov<0x141>(v)); v = fmaxf(v, dpp_mov<0x140>(v)); return v; }
DEVI float row16_sum(float v) { v += dpp_mov<0xB1>(v); v += dpp_mov<0x4E>(v); v += dpp_mov<0x141>(v); v += dpp_mov<0x140>(v); return v; }
DEVI float wave_sum(float v, int lane) {
#pragma unroll
    for (int o = 32; o >= 1; o >>= 1) v += shx(v, o, lane);
    return v;
}
DEVI int cond_of_row(int row) { return row < K::NP ? (row >> 11) : (K::BP + row - K::NP); }
DEVI int pslot_of_row(int row) { return row < K::NP ? (row & (K::SEQ - 1)) : K::SEQ; }
DEVI float rope_inv(int i) { return (float)exp2(-(double)i * (13.287712379549449 / 16.0)); }

namespace pg8 {
typedef unsigned short bf16_t;
typedef short bf16x8 __attribute__((ext_vector_type(8)));
typedef float f32x4 __attribute__((ext_vector_type(4)));
typedef unsigned u32x4 __attribute__((ext_vector_type(4)));
typedef unsigned u32x2 __attribute__((ext_vector_type(2)));
constexpr int BM = 256, BK = 64, HALF = 128, HTB = HALF * BK * 2, STAGE_BYTES = 8 * HTB, NXCD = 8, WGM = 8;
DEVI int lds_byte(int r, int c) { const int st = (r >> 4) * 2 + (c >> 5), rr = r & 15, cc = c & 31, ob = rr * 64 + cc * 2; return st * 1024 + (ob ^ (((ob >> 9) & 1) << 5)); }
DEVI void stage_rc(int b, int& R, int& C) { const int st = b / 1024, sb = b % 1024, swz = sb ^ (((sb >> 9) & 1) << 5); R = (st >> 1) * 16 + swz / 64; C = (st & 1) * 32 + (swz % 64) / 2; }
DEVI int perm32(int rho) { const int n = rho >> 4, i = rho & 15; return 8 * (i >> 2) + 4 * n + (i & 3); }
struct Unit { int pm, pn; };
struct StaticOrder {
    int nM, nN, nwg, G, c;
    DEVI void init(int M, int N, int G_, int c_) { nM = M / BM; nN = N / BM; nwg = nM * nN; G = G_; c = c_; }
    DEVI bool next(int i, Unit& u) const {
        const long L = (long)i * G + c; if (L >= nwg) return false;
        int wgid = (int)L; { const int q = nwg / NXCD, r = nwg % NXCD, xcd = wgid % NXCD, off = wgid / NXCD; wgid = (xcd < r ? xcd * (q + 1) : r * (q + 1) + (xcd - r) * q) + off; }
        const int nig = WGM * nN, gid = wgid / nig, fm = gid * WGM, gsz = (nM - fm) < WGM ? (nM - fm) : WGM;
        u.pm = fm + ((wgid % nig) % gsz); u.pn = (wgid % nig) / gsz; return true;
    }
};
DEVI unsigned cvt_pk_bf16(float lo, float hi) { typedef float f2_t __attribute__((ext_vector_type(2))); typedef __bf16 b2_t __attribute__((ext_vector_type(2)));
    const f2_t v = {lo, hi}; const b2_t r = __builtin_convertvector(v, b2_t); return __builtin_bit_cast(unsigned, r); }

template <class Epi>
DEVI void gemm_phase(LAS unsigned char* lds, const bf16_t* Ap, int lda, const bf16_t* Btp, int K, const StaticOrder& S, const Epi& E) {
    const int tid = otid(), wid = __builtin_amdgcn_readfirstlane(tid >> 6), lane = tid & 63, wr = wid >> 2, wc = wid & 3, fr = lane & 15, fq = lane >> 4;
    const int nt = K / BK;
    unsigned voffA[2], voffB[2];
#pragma unroll
    for (int i = 0; i < 2; ++i) { int R, C; stage_rc(tid * 16 + i * 8192, R, C); const int Rb = (R & ~31) + perm32(R & 31);
        voffA[i] = (unsigned)(R * lda + C) * 2u; voffB[i] = (unsigned)(Rb * K + C) * 2u; }
    const size_t kstep = (size_t)(BK * 2);
    const size_t hstepA = (size_t)HALF * lda * 2, hstepB = (size_t)HALF * K * 2;
    const size_t tstepA = 2 * hstepA, tstepB = 2 * hstepB;
    const unsigned ldsw = (unsigned)wid * 1024u;
    const int aoff = lds_byte(wr * 64 + fr, fq * 8), boff = lds_byte(wc * 32 + fr, fq * 8);
#define PG8_SA(b, h) (((b) * 2 + (h)) * HTB)
#define PG8_SB(b, h) ((4 + (b) * 2 + (h)) * HTB)
#define PG8_STAGE(bufoff, gbase, voff) do { _Pragma("unroll") for (int _i = 0; _i < 2; ++_i) \
        __builtin_amdgcn_global_load_lds((const unsigned*)((const char*)(gbase) + (voff)[_i]), (LAS unsigned*)(lds + (bufoff) + ldsw + _i * 8192), 16, 0, 0); } while (0)
#define PG8_LDA(dst, b, h) do { _Pragma("unroll") for (int m = 0; m < 4; ++m) _Pragma("unroll") for (int k = 0; k < 2; ++k) dst[m][k] = *(const LAS bf16x8*)(lds + PG8_SA(b, h) + aoff + m * 2048 + k * 1024); } while (0)
#define PG8_LDB(dst, b, h) do { _Pragma("unroll") for (int n = 0; n < 2; ++n) _Pragma("unroll") for (int k = 0; k < 2; ++k) dst[n][k] = *(const LAS bf16x8*)(lds + PG8_SB(b, h) + boff + n * 2048 + k * 1024); } while (0)
#define PG8_MMA(ai, bj, At, Bt) do { __builtin_amdgcn_s_setprio(1); _Pragma("unroll") for (int m = 0; m < 4; ++m) _Pragma("unroll") for (int n = 0; n < 2; ++n) _Pragma("unroll") for (int k = 0; k < 2; ++k) \
        acc[ai][bj][m][n] = __builtin_amdgcn_mfma_f32_16x16x32_bf16(Bt[n][k], At[m][k], acc[ai][bj][m][n], 0, 0, 0); __builtin_amdgcn_s_setprio(0); } while (0)
#define PG8_WAIT_V(n) asm volatile("s_waitcnt vmcnt(" #n ")" ::: "memory")
#define PG8_WAIT_L(n) asm volatile("s_waitcnt lgkmcnt(" #n ")" ::: "memory")
#define PG8_BAR __builtin_amdgcn_s_barrier()
#define PG8_SCHED __builtin_amdgcn_sched_barrier(0)
    Unit cur, nxt; int ui = 0;
    if (!S.next(0, cur)) return;
    f32x4 acc[2][2][4][2];
#pragma unroll
    for (int a = 0; a < 2; ++a)
#pragma unroll
        for (int b = 0; b < 2; ++b)
#pragma unroll
            for (int m = 0; m < 4; ++m)
#pragma unroll
                for (int n = 0; n < 2; ++n) acc[a][b][m][n] = (f32x4){0.f, 0.f, 0.f, 0.f};
    bf16x8 At[4][2], B0[2][2], B1[2][2];
    const char* cA = (const char*)Ap + (size_t)cur.pm * tstepA; const char* cB = (const char*)Btp + (size_t)cur.pn * tstepB;
    PG8_STAGE(PG8_SB(0, 0), cB, voffB); PG8_STAGE(PG8_SA(0, 0), cA, voffA); PG8_STAGE(PG8_SB(0, 1), cB + hstepB, voffB); PG8_STAGE(PG8_SA(0, 1), cA + hstepA, voffA);
    if (wr == 1) PG8_BAR;
    PG8_WAIT_V(4); PG8_BAR;
    PG8_STAGE(PG8_SB(1, 0), cB + kstep, voffB); PG8_STAGE(PG8_SA(1, 0), cA + kstep, voffA); PG8_STAGE(PG8_SB(1, 1), cB + hstepB + kstep, voffB);
    PG8_WAIT_V(6); PG8_BAR;
    for (;;) {
        const bool has_next = S.next(ui + 1, nxt);
        const char* nA = has_next ? (const char*)Ap + (size_t)nxt.pm * tstepA : cA; const char* nB = has_next ? (const char*)Btp + (size_t)nxt.pn * tstepB : cB;
        for (int t = 0; t < nt; t += 2) {
            const bool last = (t == nt - 2);
            const char* a1 = cA + (size_t)(t + 1) * kstep;
            const char* a2 = last ? nA : cA + (size_t)(t + 2) * kstep; const char* b2 = last ? nB : cB + (size_t)(t + 2) * kstep;
            const char* a3 = a2 + kstep; const char* b3 = b2 + kstep;
            if constexpr (Epi::HOOK) {
                if (t == E.t1 || t == E.t2) {
                    const int which = (t == E.t1) ? 0 : 1;
                    const int t2 = otid(), w2 = t2 >> 6, l2 = t2 & 63;
                    const int rb = cur.pm * BM + (w2 >> 2) * 64 + (l2 & 15), cb = cur.pn * BM + (w2 & 3) * 32 + 8 * (l2 >> 4);
                    {   u32x4 rw[16];
#pragma unroll
                        for (int ai = 0; ai < 2; ++ai)
#pragma unroll
                            for (int m = 0; m < 4; ++m)
#pragma unroll
                                for (int bj = 0; bj < 2; ++bj) rw[8 * ai + 2 * m + bj] = E.ratio_raw(which, rb + ai * HALF + m * 16, cb + bj * HALF);
                        __builtin_amdgcn_sched_barrier(0);
#pragma unroll
                        for (int ai = 0; ai < 2; ++ai)
#pragma unroll
                            for (int m = 0; m < 4; ++m)
#pragma unroll
                                for (int bj = 0; bj < 2; ++bj) { f32x4 r0, r1; Epi::unpack(rw[8 * ai + 2 * m + bj], r0, r1); acc[ai][bj][m][0] *= r0; acc[ai][bj][m][1] *= r1; }
                        __builtin_amdgcn_sched_barrier(0);
                    }
                }
            }
            PG8_LDB(B0, 0, 0); PG8_SCHED; PG8_LDA(At, 0, 0); PG8_STAGE(PG8_SA(1, 1), a1 + hstepA, voffA);
            PG8_WAIT_L(8); PG8_BAR; PG8_WAIT_L(0); PG8_MMA(0, 0, At, B0); PG8_BAR; PG8_SCHED;
            PG8_LDB(B1, 0, 1); PG8_STAGE(PG8_SB(0, 0), b2, voffB);
            PG8_BAR; PG8_WAIT_L(0); PG8_MMA(0, 1, At, B1); PG8_BAR;
            PG8_LDA(At, 0, 1); PG8_STAGE(PG8_SA(0, 0), a2, voffA);
            PG8_BAR; PG8_WAIT_L(0); PG8_MMA(1, 0, At, B0); PG8_BAR; PG8_SCHED;
            PG8_STAGE(PG8_SB(0, 1), b2 + hstepB, voffB);
            PG8_WAIT_V(6); PG8_BAR; PG8_MMA(1, 1, At, B1); PG8_BAR;
            PG8_LDB(B0, 1, 0); PG8_SCHED; PG8_LDA(At, 1, 0); PG8_STAGE(PG8_SA(0, 1), a2 + hstepA, voffA);
            PG8_WAIT_L(8); PG8_BAR; PG8_WAIT_L(0); PG8_MMA(0, 0, At, B0); PG8_BAR; PG8_SCHED;
            PG8_LDB(B1, 1, 1); PG8_STAGE(PG8_SB(1, 0), b3, voffB);
            PG8_BAR; PG8_WAIT_L(0); PG8_MMA(0, 1, At, B1); PG8_BAR;
            PG8_LDA(At, 1, 1); PG8_STAGE(PG8_SA(1, 0), a3, voffA);
            PG8_BAR; PG8_WAIT_L(0); PG8_MMA(1, 0, At, B0); PG8_BAR; PG8_SCHED;
            PG8_STAGE(PG8_SB(1, 1), b3 + hstepB, voffB);
            PG8_WAIT_V(6); PG8_BAR; PG8_MMA(1, 1, At, B1); PG8_BAR;
        }
        {
            const int t2 = otid(), w2 = t2 >> 6, l2 = t2 & 63;
            const int rb = cur.pm * BM + (w2 >> 2) * 64 + (l2 & 15), cb = cur.pn * BM + (w2 & 3) * 32 + 8 * (l2 >> 4);
            if constexpr (Epi::NL == 0) {
#pragma unroll
                for (int ai = 0; ai < 2; ++ai)
#pragma unroll
                    for (int m = 0; m < 4; ++m)
#pragma unroll
                        for (int bj = 0; bj < 2; ++bj) E.store8(rb + ai * HALF + m * 16, cb + bj * HALF, acc[ai][bj][m][0], acc[ai][bj][m][1]);
            } else {
                constexpr int MG = Epi::NL <= 2 ? 4 : 2;
#pragma unroll
                for (int ai = 0; ai < 2; ++ai)
#pragma unroll
                    for (int m0 = 0; m0 < 4; m0 += MG) {
                        f32x4 ax[2 * MG][Epi::NL];
#pragma unroll
                        for (int mm = 0; mm < MG; ++mm)
#pragma unroll
                            for (int bj = 0; bj < 2; ++bj) E.aux(rb + ai * HALF + (m0 + mm) * 16, cb + bj * HALF, ax[2 * mm + bj]);
                        __builtin_amdgcn_sched_barrier(0);
#pragma unroll
                        for (int mm = 0; mm < MG; ++mm)
#pragma unroll
                            for (int bj = 0; bj < 2; ++bj) E.store8a(rb + ai * HALF + (m0 + mm) * 16, cb + bj * HALF, acc[ai][bj][m0 + mm][0], acc[ai][bj][m0 + mm][1], ax[2 * mm + bj]);
                        __builtin_amdgcn_sched_barrier(0);
                    }
            }
        }
        if (!has_next) break;
#pragma unroll
        for (int a = 0; a < 2; ++a)
#pragma unroll
            for (int b = 0; b < 2; ++b)
#pragma unroll
                for (int m = 0; m < 4; ++m)
#pragma unroll
                    for (int n = 0; n < 2; ++n) acc[a][b][m][n] = (f32x4){0.f, 0.f, 0.f, 0.f};
        cur = nxt; cA = nA; cB = nB; ++ui;
    }
    PG8_WAIT_V(0);
    if (wr == 0) PG8_BAR;
    PG8_BAR;
#undef PG8_SA
#undef PG8_SB
#undef PG8_STAGE
#undef PG8_LDA
#undef PG8_LDB
#undef PG8_MMA
#undef PG8_WAIT_V
#undef PG8_WAIT_L
#undef PG8_BAR
#undef PG8_SCHED
}

template <int NS, class Epi>
DEVI void gemm_skinny(const bf16_t* Ap, int lda, const bf16_t* Btp, int N, int K, int row_base, int fb, const Epi& E, int nb = 0) {
    constexpr int GPB = 8 / NS, NSEG = Epi::HOOK ? 3 : 1;
    LAS f32x4* red = (LAS f32x4*)(dyn_lds + 1024);
    const int tid = otid(), wid = tid >> 6, lane = tid & 63, fr = lane & 15, fq = lane >> 4;
    const int sub = wid / NS, sp = wid % NS, ngrp = N / 32, kper = K / NS, grid = ogrid();
    const int b0 = (obid() - fb + grid) % grid, nbk = nb > 0 ? nb : grid;
    for (int g0 = b0 < nbk ? b0 * GPB : ngrp; g0 < ngrp; g0 += nbk * GPB) {
        const int grp = g0 + sub; const bool on = grp < ngrp;
        f32x4 acc[NSEG][2][2];
#pragma unroll
        for (int sg = 0; sg < NSEG; ++sg)
#pragma unroll
            for (int m = 0; m < 2; ++m)
#pragma unroll
                for (int n = 0; n < 2; ++n) acc[sg][m][n] = (f32x4){0.f, 0.f, 0.f, 0.f};
        if (on) {
            const bf16_t* a0 = Ap + (size_t)fr * lda + 8 * fq;
            const bf16_t* a1 = Ap + (size_t)(16 + fr) * lda + 8 * fq;
            const bf16_t* b0p = Btp + (size_t)(grp * 32 + perm32(fr)) * K + 8 * fq;
            const bf16_t* b1p = Btp + (size_t)(grp * 32 + perm32(16 + fr)) * K + 8 * fq;
            const int kbeg = sp * kper, kend = kbeg + kper;
#pragma unroll
            for (int sg = 0; sg < NSEG; ++sg) {
                int lo = kbeg, hi = kend;
                if constexpr (Epi::HOOK) { const int s0 = sg == 0 ? 0 : sg == 1 ? E.t1 * BK : E.t2 * BK, s1 = sg == 0 ? E.t1 * BK : sg == 1 ? E.t2 * BK : K; lo = lo > s0 ? lo : s0; hi = hi < s1 ? hi : s1; }
#pragma unroll 8
                for (int k0 = lo; k0 < hi; k0 += 32) {
                    const bf16x8 fa0 = *(const bf16x8*)(a0 + k0), fa1 = *(const bf16x8*)(a1 + k0), fb0 = *(const bf16x8*)(b0p + k0), fb1 = *(const bf16x8*)(b1p + k0);
                    acc[sg][0][0] = __builtin_amdgcn_mfma_f32_16x16x32_bf16(fb0, fa0, acc[sg][0][0], 0, 0, 0);
                    acc[sg][0][1] = __builtin_amdgcn_mfma_f32_16x16x32_bf16(fb1, fa0, acc[sg][0][1], 0, 0, 0);
                    acc[sg][1][0] = __builtin_amdgcn_mfma_f32_16x16x32_bf16(fb0, fa1, acc[sg][1][0], 0, 0, 0);
                    acc[sg][1][1] = __builtin_amdgcn_mfma_f32_16x16x32_bf16(fb1, fa1, acc[sg][1][1], 0, 0, 0);
                }
            }
        }
        __syncthreads();
#pragma unroll
        for (int sg = 0; sg < NSEG; ++sg)
#pragma unroll
            for (int mn = 0; mn < 4; ++mn) red[((wid * NSEG + sg) * 4 + mn) * 64 + lane] = acc[sg][mn >> 1][mn & 1];
        __syncthreads();
        if (on && sp == 0) {
            f32x4 v[NSEG][4];
#pragma unroll
            for (int sg = 0; sg < NSEG; ++sg)
#pragma unroll
                for (int mn = 0; mn < 4; ++mn) { f32x4 t = red[(((sub * NS) * NSEG + sg) * 4 + mn) * 64 + lane];
#pragma unroll
                    for (int s2 = 1; s2 < NS; ++s2) t += red[(((sub * NS + s2) * NSEG + sg) * 4 + mn) * 64 + lane];
                    v[sg][mn] = t; }
#pragma unroll
            for (int m = 0; m < 2; ++m) {
                f32x4 x0 = v[0][2 * m], x1 = v[0][2 * m + 1];
                if constexpr (Epi::HOOK) { f32x4 r0, r1; E.ratio(0, row_base + 16 * m + fr, grp * 32 + 8 * fq, r0, r1); x0 = x0 * r0 + v[1][2 * m]; x1 = x1 * r1 + v[1][2 * m + 1];
                    E.ratio(1, row_base + 16 * m + fr, grp * 32 + 8 * fq, r0, r1); x0 = x0 * r0 + v[2][2 * m]; x1 = x1 * r1 + v[2][2 * m + 1]; }
                if constexpr (Epi::NL == 0) E.store8(row_base + 16 * m + fr, grp * 32 + 8 * fq, x0, x1);
                else { f32x4 ax[Epi::NL]; E.aux(row_base + 16 * m + fr, grp * 32 + 8 * fq, ax); E.store8a(row_base + 16 * m + fr, grp * 32 + 8 * fq, x0, x1, ax); }
            }
        }
    }
    __syncthreads();
}
}

using pg8::bf16_t; using pg8::f32x4; using pg8::u32x4; using pg8::u32x2; using pg8::cvt_pk_bf16;
DEVI bf16_t f2bf(float f) { unsigned u = __float_as_uint(f); u += 0x7FFFu + ((u >> 16) & 1u); return (bf16_t)(u >> 16); }
DEVI float fast_sigmoid(float x) { return __builtin_amdgcn_rcpf(1.0f + __expf(-x)); }
DEVI float neg_expm1_small(float x) {
    if (x > -0.3f) { const float p = 1.0f + x * (0.5f + x * (0.16666667f + x * (0.041666668f + x * (0.0083333338f + x * 0.0013888889f)))); return -x * p; }
    return 1.0f - __expf(x);
}
DEVI float fast_softplus(float x) { return fmaxf(x, 0.f) + __logf(1.0f + __expf(-fabsf(x))); }
namespace K { constexpr int NINP = 10496, WIN_SZ = NINP * 1024, WPR_SZ = 1024 * 3328, WO_SZ = 1024 * 1024, WFI_SZ = 5632 * 1024, WFO_SZ = 1024 * 2816; }

namespace K { constexpr int UC_RY = 1280, UC_QKV = 2560, UC_GZ = 5632, UC_SM = 9728, USMW = 688, SM_A = 0, SM_B = 8, SM_MQ = 16, SM_MKV = 400; }
DEVI float fast_gelu_tanh(float x) { const float u = 1.5957691216057308f * (x + 0.044715f * x * x * x); return x * __builtin_amdgcn_rcpf(1.0f + __expf(-u)); }
struct EpiU { static constexpr bool HOOK = false; static constexpr int NL = 0; bf16_t* URX; bf16_t* GY; bf16_t* UQKV; bf16_t* SZ; bf16_t* R1; bf16_t* R2; bf16_t* R3; float* USM;
    DEVI void store8(int row, int col0, f32x4 v0, f32x4 v1) const {
        using namespace K;
        if (col0 < UC_GZ) {
            u32x4 w; w.x = cvt_pk_bf16(v0[0], v0[1]); w.y = cvt_pk_bf16(v0[2], v0[3]); w.z = cvt_pk_bf16(v1[0], v1[1]); w.w = cvt_pk_bf16(v1[2], v1[3]);
            bf16_t* dst = col0 < UC_RY ? URX + (size_t)row * DRNN + col0 : col0 < UC_QKV ? GY + (size_t)row * DRNN + (col0 - UC_RY) : UQKV + (size_t)row * GC + (col0 - UC_QKV);
            *(u32x4*)dst = w;
        } else if (col0 < UC_SM) {
            const size_t o = (size_t)row * D + ((col0 - UC_GZ) >> 2);
            const float ea0 = __expf(-v0[0]), ea1 = __expf(-v0[1]), eb0 = __expf(-v0[2]), eb1 = __expf(-v0[3]), ec0 = __expf(-v1[0]), ec1 = __expf(-v1[1]);
            const float ia0 = __builtin_amdgcn_rcpf(1.0f + ea0), ia1 = __builtin_amdgcn_rcpf(1.0f + ea1), ib0 = __builtin_amdgcn_rcpf(1.0f + eb0), ib1 = __builtin_amdgcn_rcpf(1.0f + eb1), ic0 = __builtin_amdgcn_rcpf(1.0f + ec0), ic1 = __builtin_amdgcn_rcpf(1.0f + ec1);
            *(unsigned*)(R1 + o) = cvt_pk_bf16((1.0f + eb0) * ia0, (1.0f + eb1) * ia1);
            *(unsigned*)(R2 + o) = cvt_pk_bf16((1.0f + ec0) * ib0, (1.0f + ec1) * ib1);
            *(unsigned*)(R3 + o) = cvt_pk_bf16(ic0, ic1);
            *(unsigned*)(SZ + o) = cvt_pk_bf16(v1[2], v1[3]);
        } else if (col0 < NIN) {
            u32x4 w; w.x = cvt_pk_bf16(v0[0], v0[1]); w.y = cvt_pk_bf16(v0[2], v0[3]); w.z = cvt_pk_bf16(v1[0], v1[1]); w.w = cvt_pk_bf16(v1[2], v1[3]);
            *(u32x4*)((bf16_t*)USM + (size_t)row * USMW + (col0 - UC_SM)) = w;
        }
    } };
struct EpiF32 { static constexpr bool HOOK = false; static constexpr int NL = 0; float* C; int ldc;
    DEVI void store8(int row, int col0, f32x4 v0, f32x4 v1) const { float* p = C + (size_t)row * ldc + col0; *(f32x4*)p = v0; *(f32x4*)(p + 4) = v1; } };
struct EpiBf16 { static constexpr bool HOOK = false; static constexpr int NL = 0; bf16_t* C; int ldc;
    DEVI void store8(int row, int col0, f32x4 v0, f32x4 v1) const { u32x4 w; w.x = cvt_pk_bf16(v0[0], v0[1]); w.y = cvt_pk_bf16(v0[2], v0[3]); w.z = cvt_pk_bf16(v1[0], v1[1]); w.w = cvt_pk_bf16(v1[2], v1[3]);
        *(u32x4*)(C + (size_t)row * ldc + col0) = w; } };
struct EpiK { static constexpr bool HOOK = false; static constexpr int NL = 0; bf16_t* Kb;
    DEVI void store8(int row, int col0, f32x4 v0, f32x4 v1) const { u32x4 w; w.x = cvt_pk_bf16(v0[0], v0[1]); w.y = cvt_pk_bf16(v0[2], v0[3]); w.z = cvt_pk_bf16(v1[0], v1[1]); w.w = cvt_pk_bf16(v1[2], v1[3]);
        *(u32x4*)(Kb + (size_t)row * 768 + (col0 >> 6) * 96 + (col0 & 63)) = w; } };
struct EpiQ { static constexpr bool HOOK = false; static constexpr int NL = 2; bf16_t* Qb; const float* ROT;
    DEVI void aux(int row, int col0, f32x4* a) const { const int h = col0 / 96, d0 = col0 - 96 * h; const float* cs = ROT + (size_t)(pslot_of_row(row) * 16 + (d0 >= 64 ? (d0 - 64) >> 1 : 0)) * 2;
        a[0] = *(const f32x4*)cs; a[1] = *(const f32x4*)(cs + 4); }
    DEVI void store8a(int row, int col0, f32x4 v0, f32x4 v1, const f32x4* a) const {
        const int h = col0 / 96, d0 = col0 - 96 * h; float o[8] = {v0[0], v0[1], v0[2], v0[3], v1[0], v1[1], v1[2], v1[3]};
        if (d0 >= 64) { const float cs[8] = {a[0][0], a[0][1], a[0][2], a[0][3], a[1][0], a[1][1], a[1][2], a[1][3]};
#pragma unroll
            for (int k = 0; k < 4; ++k) { const float c = cs[2 * k], sn = cs[2 * k + 1], x1 = o[2 * k], x2 = o[2 * k + 1]; o[2 * k] = x1 * c - x2 * sn; o[2 * k + 1] = x2 * c + x1 * sn; } }
        const float sc = 0.10206207261596577f * 1.4426950408889634f;
        u32x4 w; w.x = cvt_pk_bf16(o[0] * sc, o[1] * sc); w.y = cvt_pk_bf16(o[2] * sc, o[3] * sc); w.z = cvt_pk_bf16(o[4] * sc, o[5] * sc); w.w = cvt_pk_bf16(o[6] * sc, o[7] * sc);
        *(u32x4*)(Qb + (size_t)row * 768 + col0) = w; } };
struct EpiProj { static constexpr bool HOOK = true; static constexpr int NL = 1; int t1, t2; const bf16_t* R1; const bf16_t* R2; const bf16_t* R3; bf16_t* M;
    static DEVI void unpack(u32x4 w, f32x4& r0, f32x4& r1) { r0[0] = __uint_as_float(w.x << 16); r0[1] = __uint_as_float(w.x & 0xffff0000u); r0[2] = __uint_as_float(w.y << 16); r0[3] = __uint_as_float(w.y & 0xffff0000u);
        r1[0] = __uint_as_float(w.z << 16); r1[1] = __uint_as_float(w.z & 0xffff0000u); r1[2] = __uint_as_float(w.w << 16); r1[3] = __uint_as_float(w.w & 0xffff0000u); }
    DEVI void ratio(int which, int row, int col0, f32x4& r0, f32x4& r1) const { const u32x4 w = *(const u32x4*)((which == 0 ? R1 : R2) + (size_t)row * 1024 + col0); unpack(w, r0, r1); }
    DEVI u32x4 ratio_raw(int which, int row, int col0) const { return *(const u32x4*)((which == 0 ? R1 : R2) + (size_t)row * 1024 + col0); }
    DEVI void aux(int row, int col0, f32x4* a) const { const u32x4 w = *(const u32x4*)(R3 + (size_t)row * 1024 + col0); a[0] = (f32x4){__uint_as_float(w.x), __uint_as_float(w.y), __uint_as_float(w.z), __uint_as_float(w.w)}; }
    DEVI void store8a(int row, int col0, f32x4 v0, f32x4 v1, const f32x4* a) const { u32x4 rw = {__float_as_uint(a[0][0]), __float_as_uint(a[0][1]), __float_as_uint(a[0][2]), __float_as_uint(a[0][3])}; f32x4 r0, r1; unpack(rw, r0, r1); v0 *= r0; v1 *= r1;
        u32x4 w; w.x = cvt_pk_bf16(v0[0], v0[1]); w.y = cvt_pk_bf16(v0[2], v0[3]); w.z = cvt_pk_bf16(v1[0], v1[1]); w.w = cvt_pk_bf16(v1[2], v1[3]); *(u32x4*)(M + (size_t)row * 1024 + col0) = w; } };
struct EpiRes { static constexpr bool HOOK = false; static constexpr int NL = 4; const float* xi; const float* xis; float* xo; const float* modchunk; int xi_bf, xo_bf;
    DEVI void aux(int row, int col0, f32x4* a) const { const float* g = modchunk + (size_t)cond_of_row(row) * 6 * K::D + col0;
        if (xi_bf) { const u32x4 w = *(const u32x4*)((const bf16_t*)xi + (size_t)row * K::D + col0); a[0] = (f32x4){__uint_as_float(w.x), __uint_as_float(w.y), __uint_as_float(w.z), __uint_as_float(w.w)}; a[1] = a[0]; }
        else { const float* x = (row < K::NP ? xi : xis) + (size_t)row * K::D + col0; a[0] = *(const f32x4*)x; a[1] = *(const f32x4*)(x + 4); }
        a[2] = *(const f32x4*)g; a[3] = *(const f32x4*)(g + 4); }
    DEVI void store8a(int row, int col0, f32x4 v0, f32x4 v1, const f32x4* a) const {
        f32x4 x0 = a[0], x1 = a[1];
        if (xi_bf) { const unsigned w0 = __float_as_uint(a[0][0]), w1 = __float_as_uint(a[0][1]), w2 = __float_as_uint(a[0][2]), w3 = __float_as_uint(a[0][3]);
            x0 = (f32x4){__uint_as_float(w0 << 16), __uint_as_float(w0 & 0xffff0000u), __uint_as_float(w1 << 16), __uint_as_float(w1 & 0xffff0000u)};
            x1 = (f32x4){__uint_as_float(w2 << 16), __uint_as_float(w2 & 0xffff0000u), __uint_as_float(w3 << 16), __uint_as_float(w3 & 0xffff0000u)}; }
        const f32x4 r0 = x0 + a[2] * v0, r1 = x1 + a[3] * v1;
        if (xo_bf) { u32x4 w; w.x = cvt_pk_bf16(r0[0], r0[1]); w.y = cvt_pk_bf16(r0[2], r0[3]); w.z = cvt_pk_bf16(r1[0], r1[1]); w.w = cvt_pk_bf16(r1[2], r1[3]); *(u32x4*)((bf16_t*)xo + (size_t)row * K::D + col0) = w; }
        else { float* o = xo + (size_t)row * K::D + col0; *(f32x4*)o = r0; *(f32x4*)(o + 4) = r1; } } };
struct EpiFfnIn { static constexpr bool HOOK = false; static constexpr int NL = 0; bf16_t* ACT;
    DEVI void store8(int row, int col0, f32x4 v0, f32x4 v1) const { float a[4];
#pragma unroll
        for (int i = 0; i < 4; ++i) a[i] = v0[i] * fast_sigmoid(v0[i]) * v1[i];
        u32x2 w; w.x = cvt_pk_bf16(a[0], a[1]); w.y = cvt_pk_bf16(a[2], a[3]); *(u32x2*)(ACT + (size_t)row * K::DFF + (col0 >> 1)) = w; } };

struct ConvCtx { int rot, vb, vgrid; };
template <class ColMap, class VecTile>
DEVI void conv_wT(ConvCtx& cx, const float* src, int ldsrc, int Ksrc, bf16_t* dst, int ldd, int koff, int Npad, ColMap cm, VecTile vt) {
    LAS unsigned short* T = (LAS unsigned short*)(dyn_lds + 1024);
    const int tid = otid(), grid = cx.vgrid, bid = (cx.vb - cx.rot + grid) % grid;
    const int tk = Ksrc / 64, tn = Npad / 64, nt = tk * tn;
    cx.rot = (cx.rot + nt) % grid;
    const int kk = tid >> 3, ng = (tid & 7) * 8, nn = tid >> 3, k8 = (tid & 7) * 8;
    float va[8], vb[8];
    auto ld = [&](int t, float* v) { const int n0 = (t / tk) * 64, k0 = (t % tk) * 64; const float* sp = src + (size_t)(k0 + kk) * ldsrc;
        if (vt(n0)) { const int s0 = cm(n0 + ng), s1 = cm(n0 + ng + 4);
            const float4 a = s0 >= 0 ? *(const float4*)(sp + s0) : make_float4(0.f, 0.f, 0.f, 0.f), b = s1 >= 0 ? *(const float4*)(sp + s1) : make_float4(0.f, 0.f, 0.f, 0.f);
            v[0] = a.x; v[1] = a.y; v[2] = a.z; v[3] = a.w; v[4] = b.x; v[5] = b.y; v[6] = b.z; v[7] = b.w; }
        else {
#pragma unroll
            for (int e = 0; e < 8; ++e) { const int sc = cm(n0 + ng + e); v[e] = sc >= 0 ? sp[sc] : 0.f; } } };
    if (bid < nt) ld(bid, va);
    if (bid + grid < nt) ld(bid + grid, vb);
    for (int t = bid; t < nt; t += 2 * grid) {
        const bool two = t + grid < nt;
#pragma unroll
        for (int e = 0; e < 8; ++e) T[(ng + e) * 72 + kk] = f2bf(va[e]);
        if (two) {
#pragma unroll
            for (int e = 0; e < 8; ++e) T[64 * 72 + (ng + e) * 72 + kk] = f2bf(vb[e]); }
        if (t + 2 * grid < nt) ld(t + 2 * grid, va);
        if (t + 3 * grid < nt) ld(t + 3 * grid, vb);
        lds_barrier();
        { const int n0 = (t / tk) * 64, k0 = (t % tk) * 64; const u32x4 w = *(const LAS u32x4*)(T + nn * 72 + k8); *(u32x4*)(dst + (size_t)(n0 + nn) * ldd + koff + k0 + k8) = w; }
        if (two) { const int t2 = t + grid, n0 = (t2 / tk) * 64, k0 = (t2 % tk) * 64; const u32x4 w = *(const LAS u32x4*)(T + 64 * 72 + nn * 72 + k8); *(u32x4*)(dst + (size_t)(n0 + nn) * ldd + koff + k0 + k8) = w; }
        lds_barrier();
    }
}
NOINL void ph_convert(ConvCtx& rot, int l, int part) {
    using namespace K;
    if (part == 0) {
        conv_wT(rot, uni(PRM.w_in) + (size_t)l * D * NIN, NIN, D, uni(PRM.WIN) + (size_t)l * WIN_SZ, D, 0, NINP, [](int n) {
            if (n < UC_GZ) return n;
            if (n < UC_SM) { const int q = n - UC_GZ, d = 2 * (q >> 3) + (q & 1), g = (q & 7) >> 1; return g == 0 ? U_GATE + d : g == 1 ? U_GATE + D + d : g == 2 ? U_GATE + 2 * D + d : U_Z + d; }
            return n < NIN ? U_A + (n - UC_SM) : -1; }, [](int n0) { return n0 < UC_GZ || n0 >= UC_SM; });
        conv_wT(rot, uni(PRM.w_rg_proj) + (size_t)l * DRNN * D, D, DRNN, uni(PRM.WPR) + (size_t)l * WPR_SZ, CATW, CAT_RG, D, [](int n) { return n; }, [](int) { return true; });
        conv_wT(rot, uni(PRM.w_gdn_proj) + (size_t)l * GVW * D, D, GVW, uni(PRM.WPR) + (size_t)l * WPR_SZ, CATW, CAT_GDN, D, [](int n) { return n; }, [](int) { return true; });
        conv_wT(rot, uni(PRM.w_mla_proj) + (size_t)l * 1024 * D, D, 1024, uni(PRM.WPR) + (size_t)l * WPR_SZ, CATW, CAT_MLA, D, [](int n) { return n; }, [](int) { return true; });
        conv_wT(rot, uni(PRM.w_o) + (size_t)l * D * D, D, D, uni(PRM.WO) + (size_t)l * WO_SZ, D, 0, D, [](int n) { return n; }, [](int) { return true; });
    } else {
        conv_wT(rot, uni(PRM.w_ffn_in) + (size_t)l * D * 2 * DFF, 2 * DFF, D, uni(PRM.WFI) + (size_t)l * WFI_SZ, D, 0, 2 * DFF, [](int n) { const int j = n >> 3, e = n & 7; return e < 4 ? 4 * j + e : DFF + 4 * j + (e - 4); }, [](int) { return true; });
        conv_wT(rot, uni(PRM.w_ffn_out) + (size_t)l * DFF * D, D, DFF, uni(PRM.WFO) + (size_t)l * WFO_SZ, DFF, 0, D, [](int n) { return n; }, [](int) { return true; });
        conv_wT(rot, uni(PRM.w_uq) + (size_t)l * QL * 768, 768, QL, uni(PRM.WUQ) + (size_t)l * 768 * QL, QL, 0, 768, [](int n) { return n; }, [](int) { return true; });
        conv_wT(rot, uni(PRM.w_uq) + (size_t)l * QL * 768, 768, QL, uni(PRM.WUQP) + (size_t)l * 768 * QL, QL, 0, 768,
                [](int n) { const int h = n / 96, d = n - 96 * h; return d < 64 ? n : h * 96 + 64 + ((d - 64) >> 1) + 16 * ((d - 64) & 1); }, [](int) { return false; });
        conv_wT(rot, uni(PRM.w_ukv) + (size_t)l * KVL * 1536, 1536, KVL, uni(PRM.WK) + (size_t)l * 512 * KVL, KVL, 0, 512, [](int n) { return (n >> 6) * 192 + (n & 63); }, [](int) { return true; });
        conv_wT(rot, uni(PRM.w_ukv) + (size_t)l * KVL * 1536, 1536, KVL, uni(PRM.WV) + (size_t)l * 1024 * KVL, KVL, 0, 1024, [](int n) { return (n >> 7) * 192 + 64 + (n & 127); }, [](int) { return true; });
        for (int n = 0; n < RGN; ++n) {
            conv_wT(rot, uni(PRM.rg_wa) + ((size_t)l * RGN + n) * RGB * RGB, RGB, RGB, uni(PRM.WRG) + ((size_t)l * RGN + n) * 256 * 128, RGB, 0, RGB, [](int c) { return c; }, [](int) { return true; });
            conv_wT(rot, uni(PRM.rg_wx) + ((size_t)l * RGN + n) * RGB * RGB, RGB, RGB, uni(PRM.WRG) + ((size_t)l * RGN + n) * 256 * 128 + 128 * 128, RGB, 0, RGB, [](int c) { return c; }, [](int) { return true; });
        }
    }
}

template <class Epi>
DEVI void gemm_f32(const float* __restrict__ A, int lda, int M, const float* __restrict__ B, int ldb, int N, int Kd, float* lds, Epi epi) {
    float* As = lds; float* Bs = lds + 16 * 132;
    const int tid = otid(), tx = tid & 31, ty = tid >> 5;
    const int tm = (M + 127) / 128, tn = (N + 127) / 128, ntiles = tm * tn;
    const int ar = tid >> 2, ak = (tid & 3) * 4, bk = tid >> 5, bc = (tid & 31) * 4;
    const int bid_ = obid(), grid_ = ogrid();
    for (int tile = bid_; tile < ntiles; tile += grid_) {
        const int pm = tile / tn, pn = tile % tn, row0 = pm * 128, col0 = pn * 128;
        float acc[8][4];
#pragma unroll
        for (int i = 0; i < 8; ++i)
#pragma unroll
            for (int j = 0; j < 4; ++j) acc[i][j] = 0.f;
        for (int k0 = 0; k0 < Kd; k0 += 16) {
            float4 av = make_float4(0.f, 0.f, 0.f, 0.f), bv = make_float4(0.f, 0.f, 0.f, 0.f);
            if (row0 + ar < M) av = *(const float4*)(A + (size_t)(row0 + ar) * lda + k0 + ak);
            if (col0 + bc < N) bv = *(const float4*)(B + (size_t)(k0 + bk) * ldb + col0 + bc);
            __syncthreads();
            As[(ak + 0) * 132 + ar] = av.x; As[(ak + 1) * 132 + ar] = av.y; As[(ak + 2) * 132 + ar] = av.z; As[(ak + 3) * 132 + ar] = av.w;
            *(float4*)(Bs + bk * 128 + bc) = bv;
            __syncthreads();
#pragma unroll
            for (int kk = 0; kk < 16; ++kk) {
                const float4 a0 = *(const float4*)(As + kk * 132 + ty * 8), a1 = *(const float4*)(As + kk * 132 + ty * 8 + 4);
                const float4 b = *(const float4*)(Bs + kk * 128 + tx * 4);
                const float a[8] = {a0.x, a0.y, a0.z, a0.w, a1.x, a1.y, a1.z, a1.w};
                const float bb[4] = {b.x, b.y, b.z, b.w};
#pragma unroll
                for (int i = 0; i < 8; ++i)
#pragma unroll
                    for (int j = 0; j < 4; ++j) acc[i][j] = fmaf(a[i], bb[j], acc[i][j]);
            }
        }
#pragma unroll
        for (int i = 0; i < 8; ++i) {
            const int row = row0 + ty * 8 + i;
            if (row < M) {
#pragma unroll
                for (int j = 0; j < 4; ++j) { const int col = col0 + tx * 4 + j; if (col < N) epi(row, col, acc[i][j]); }
            }
        }
    }
    __syncthreads();
}

typedef float f32x16 __attribute__((ext_vector_type(16)));
namespace at { constexpr int KROW = 208, VROW = 144, KBUF = 64 * KROW, VBUF = 128 * VROW, VOFF = 2 * KBUF; }
DEVI void attn_prompt_block(const bf16_t* Qb, const bf16_t* Kb, const bf16_t* Vt, bf16_t* CAT, int b, int h, int qb, int tid) {
    using namespace K; using namespace at;
    LAS unsigned char* lds = (LAS unsigned char*)(dyn_lds + 1024);
    const int lane = tid & 63, w = tid >> 6, r = lane & 31, hi = lane >> 5;
    const int q0 = qb * 256 + w * 32, qpos = q0 + r;
    const int ntile = qb * 4 + 4;
    const int kc0 = tid, kc1 = 512 + tid; const bool k1on = tid < 256;
    const int kk0 = kc0 / 12, kp0 = kc0 - 12 * kk0, kk1 = kc1 / 12, kp1 = kc1 - 12 * kk1;
    const unsigned kg0 = (unsigned)((b * SEQ + kk0) * 768 + h * 96 + kp0 * 8);
    const unsigned kg1 = (unsigned)((b * SEQ + (k1on ? kk1 : 0)) * 768 + h * 96 + kp1 * 8);
    const int ve0 = tid >> 3, vp = tid & 7;
    const unsigned vg0 = (unsigned)((h * 128 + ve0) * NP + b * SEQ + vp * 8), vg1 = vg0 + 64u * NP;
    const int ksl0 = kk0 * KROW + kp0 * 16, ksl1 = kk1 * KROW + kp1 * 16, vsl0 = VOFF + ve0 * VROW + vp * 16, vsl1 = vsl0 + 64 * VROW;
    pg8::bf16x8 qf[6];
    { const bf16_t* qp = Qb + (size_t)(b * SEQ + qpos) * 768 + h * 96 + 8 * hi;
#pragma unroll
      for (int ks = 0; ks < 6; ++ks) qf[ks] = *(const pg8::bf16x8*)(qp + 16 * ks); }
    f32x16 O[4];
#pragma unroll
    for (int eb = 0; eb < 4; ++eb)
#pragma unroll
        for (int i = 0; i < 16; ++i) O[eb][i] = 0.f;
    float m = -1e30f, l = 0.f;
    u32x4 sk0, sk1 = {0u, 0u, 0u, 0u}, sv0, sv1;
    sk0 = *(const u32x4*)(Kb + kg0); if (k1on) sk1 = *(const u32x4*)(Kb + kg1); sv0 = *(const u32x4*)(Vt + vg0); sv1 = *(const u32x4*)(Vt + vg1);
    __syncthreads();
    *(LAS u32x4*)(lds + ksl0) = sk0; if (k1on) *(LAS u32x4*)(lds + ksl1) = sk1; *(LAS u32x4*)(lds + vsl0) = sv0; *(LAS u32x4*)(lds + vsl1) = sv1;
    __syncthreads();
    for (int j = 0; j < ntile; ++j) {
        const int k0 = j * 64, kbo = (j & 1) * KBUF, vbo = VOFF + (j & 1) * VBUF;
        const bool more = j + 1 < ntile;
        if (more) { const unsigned ko = (unsigned)(k0 + 64) * 768u; sk0 = *(const u32x4*)(Kb + (kg0 + ko)); if (k1on) sk1 = *(const u32x4*)(Kb + (kg1 + ko));
                    sv0 = *(const u32x4*)(Vt + (vg0 + (unsigned)(k0 + 64))); sv1 = *(const u32x4*)(Vt + (vg1 + (unsigned)(k0 + 64))); }
        if (k0 <= q0 + 31) {
            f32x16 p0, p1;
#pragma unroll
            for (int i = 0; i < 16; ++i) { p0[i] = 0.f; p1[i] = 0.f; }
            {   pg8::bf16x8 ka0[6], ka1[6];
#pragma unroll
                for (int ks = 0; ks < 6; ++ks) { ka0[ks] = *(const LAS pg8::bf16x8*)(lds + kbo + r * KROW + ks * 32 + hi * 16); ka1[ks] = *(const LAS pg8::bf16x8*)(lds + kbo + (32 + r) * KROW + ks * 32 + hi * 16); }
                __builtin_amdgcn_sched_barrier(0);
#pragma unroll
                for (int ks = 0; ks < 6; ++ks) { p0 = __builtin_amdgcn_mfma_f32_32x32x16_bf16(ka0[ks], qf[ks], p0, 0, 0, 0); p1 = __builtin_amdgcn_mfma_f32_32x32x16_bf16(ka1[ks], qf[ks], p1, 0, 0, 0); }
                __builtin_amdgcn_sched_barrier(0);
            }
            if (k0 + 63 > q0) {
                const int dq = qpos - k0 - 4 * hi;
#pragma unroll
                for (int i = 0; i < 16; ++i) { const int c = (i & 3) + 8 * (i >> 2); if (c > dq) p0[i] = -INFINITY; if (c + 32 > dq) p1[i] = -INFINITY; }
            }
            float mx = p0[0];
#pragma unroll
            for (int i = 1; i < 16; ++i) mx = fmaxf(mx, p0[i]);
#pragma unroll
            for (int i = 0; i < 16; ++i) mx = fmaxf(mx, p1[i]);
            mx = fmaxf(mx, shx(mx, 32, lane));
            const float mn = mx > m + 8.0f ? mx : m;
            if (__builtin_amdgcn_ballot_w64(mn != m) != 0ull) {
                const float alpha = __builtin_amdgcn_exp2f(m - mn); m = mn; l *= alpha;
#pragma unroll
                for (int eb = 0; eb < 4; ++eb)
#pragma unroll
                    for (int i = 0; i < 16; ++i) O[eb][i] *= alpha;
            }
            float ps = 0.f;
#pragma unroll
            for (int i = 0; i < 16; ++i) { p0[i] = __builtin_amdgcn_exp2f(p0[i] - mn); p1[i] = __builtin_amdgcn_exp2f(p1[i] - mn); ps += p0[i] + p1[i]; }
            ps += shx(ps, 32, lane);
            l += ps;
            pg8::bf16x8 pf[4];
            { u32x4 t;
              t.x = cvt_pk_bf16(p0[0], p0[1]); t.y = cvt_pk_bf16(p0[2], p0[3]); t.z = cvt_pk_bf16(p0[4], p0[5]); t.w = cvt_pk_bf16(p0[6], p0[7]); pf[0] = *(pg8::bf16x8*)&t;
              t.x = cvt_pk_bf16(p0[8], p0[9]); t.y = cvt_pk_bf16(p0[10], p0[11]); t.z = cvt_pk_bf16(p0[12], p0[13]); t.w = cvt_pk_bf16(p0[14], p0[15]); pf[1] = *(pg8::bf16x8*)&t;
              t.x = cvt_pk_bf16(p1[0], p1[1]); t.y = cvt_pk_bf16(p1[2], p1[3]); t.z = cvt_pk_bf16(p1[4], p1[5]); t.w = cvt_pk_bf16(p1[6], p1[7]); pf[2] = *(pg8::bf16x8*)&t;
              t.x = cvt_pk_bf16(p1[8], p1[9]); t.y = cvt_pk_bf16(p1[10], p1[11]); t.z = cvt_pk_bf16(p1[12], p1[13]); t.w = cvt_pk_bf16(p1[14], p1[15]); pf[3] = *(pg8::bf16x8*)&t; }
#pragma unroll
            for (int sh = 0; sh < 2; ++sh) {
                u32x2 vlo[2][4], vhi[2][4];
#pragma unroll
                for (int s2 = 0; s2 < 2; ++s2)
#pragma unroll
                    for (int eb = 0; eb < 4; ++eb) { const LAS unsigned char* vp_ = lds + vbo + (32 * eb + r) * VROW + (16 * (2 * sh + s2) + 4 * hi) * 2; vlo[s2][eb] = *(const LAS u32x2*)vp_; vhi[s2][eb] = *(const LAS u32x2*)(vp_ + 16); }
                __builtin_amdgcn_sched_barrier(0);
#pragma unroll
                for (int s2 = 0; s2 < 2; ++s2)
#pragma unroll
                    for (int eb = 0; eb < 4; ++eb) { u32x4 t; t.x = vlo[s2][eb].x; t.y = vlo[s2][eb].y; t.z = vhi[s2][eb].x; t.w = vhi[s2][eb].y;
                        O[eb] = __builtin_amdgcn_mfma_f32_32x32x16_bf16(*(pg8::bf16x8*)&t, pf[2 * sh + s2], O[eb], 0, 0, 0); }
                __builtin_amdgcn_sched_barrier(0);
            }
        }
        if (more) { const int nb = ((j + 1) & 1); *(LAS u32x4*)(lds + nb * KBUF + ksl0) = sk0; if (k1on) *(LAS u32x4*)(lds + nb * KBUF + ksl1) = sk1;
                    *(LAS u32x4*)(lds + nb * VBUF + vsl0) = sv0; *(LAS u32x4*)(lds + nb * VBUF + vsl1) = sv1; }
        __syncthreads();
    }
    const float il = 1.0f / l;
    bf16_t* op = CAT + (size_t)(b * SEQ + qpos) * CATW + CAT_MLA + h * 128 + 4 * hi;
#pragma unroll
    for (int eb = 0; eb < 4; ++eb)
#pragma unroll
        for (int g = 0; g < 4; ++g) { u32x2 t; t.x = cvt_pk_bf16(O[eb][4 * g] * il, O[eb][4 * g + 1] * il); t.y = cvt_pk_bf16(O[eb][4 * g + 2] * il, O[eb][4 * g + 3] * il);
            *(u32x2*)(op + 32 * eb + 8 * g) = t; }
}

NOINL void ph_gdn_sample(int layer, int u0, int ust) {
    using namespace K;
    const int tid = otid();
    if (tid >= 256) return;
    const int j = tid >> 1, hf = tid & 1, lane = tid & 63; const int bid_ = obid(), grid_ = ogrid();
    const float* stS = uni(PRM.state_gdn_S); const float* GB = uni(PRM.GB); const float* QKVC = uni(PRM.QKVC); float* OG = uni(PRM.OG); float* out = uni(PRM.out);
    for (int unit = BP * GH + u0; unit < (BP + BS) * GH; unit += ust) {
        const int seq = unit >> 3, h = unit & 7;
        const bool prompt = seq < BP;
        const int T = prompt ? SEQ : 1, row0 = prompt ? seq * SEQ : NP + (seq - BP);
        float S[64];
        if (prompt) {
#pragma unroll
            for (int d = 0; d < 64; ++d) S[d] = 0.f;
        } else {
            const float* sp = stS + ((size_t)(layer * BS + (seq - BP)) * GH + h) * GDK * GDV + (size_t)(hf * 64) * GDV + j;
#pragma unroll
            for (int d = 0; d < 64; ++d) S[d] = sp[(size_t)d * GDV];
        }
        for (int t = 0; t < T; ++t) {
            const int row = row0 + t;
            const float g = GB[(size_t)row * 16 + h], beta = GB[(size_t)row * 16 + 8 + h], eg = __expf(g);
            const float4* qv = (const float4*)(QKVC + (size_t)row * GC + h * 128 + hf * 64);
            const float4* kv = (const float4*)(QKVC + (size_t)row * GC + GKW + h * 128 + hf * 64);
            const float v = QKVC[(size_t)row * GC + 2 * GKW + h * 128 + j];
            float dot = 0.f;
#pragma unroll
            for (int d4 = 0; d4 < 16; ++d4) {
                const float4 k4 = kv[d4];
                S[4 * d4 + 0] *= eg; S[4 * d4 + 1] *= eg; S[4 * d4 + 2] *= eg; S[4 * d4 + 3] *= eg;
                dot = fmaf(S[4 * d4 + 0], k4.x, dot); dot = fmaf(S[4 * d4 + 1], k4.y, dot); dot = fmaf(S[4 * d4 + 2], k4.z, dot); dot = fmaf(S[4 * d4 + 3], k4.w, dot);
            }
            dot += shx(dot, 1, lane);
            const float u = beta * (v - dot);
            float o = 0.f;
#pragma unroll
            for (int d4 = 0; d4 < 16; ++d4) {
                const float4 k4 = kv[d4], q4 = qv[d4];
                S[4 * d4 + 0] = fmaf(k4.x, u, S[4 * d4 + 0]); S[4 * d4 + 1] = fmaf(k4.y, u, S[4 * d4 + 1]); S[4 * d4 + 2] = fmaf(k4.z, u, S[4 * d4 + 2]); S[4 * d4 + 3] = fmaf(k4.w, u, S[4 * d4 + 3]);
                o = fmaf(S[4 * d4 + 0], q4.x, o); o = fmaf(S[4 * d4 + 1], q4.y, o); o = fmaf(S[4 * d4 + 2], q4.z, o); o = fmaf(S[4 * d4 + 3], q4.w, o);
            }
            o += shx(o, 1, lane);
            if (hf == 0) ((bf16_t*)OG)[(size_t)row * GVW + h * 128 + j] = f2bf(o);
        }
        float* so = (prompt ? out + O_GSP + ((size_t)(layer * BP + seq) * GH + h) * GDK * GDV
                            : out + O_GSS + ((size_t)(layer * BS + (seq - BP)) * GH + h) * GDK * GDV) + (size_t)(hf * 64) * GDV + j;
#pragma unroll
        for (int d = 0; d < 64; ++d) so[(size_t)d * GDV] = S[d];
    }
}

namespace gd { constexpr int NCH = 2048, UT_SZ = 128 * 64, WT_SZ = 64 * 128, KDT_SZ = 128 * 64, AQ_SZ = 64 * 64;
    constexpr int WROW = 272, KROW = 144, AROW = 144, B_WT = 0, B_QG = 64 * WROW, B_KD = 2 * 64 * WROW, B_AQ = B_KD + 128 * KROW, BUFSZ = B_AQ + 64 * AROW; }
NOINL void ph_gdn_prep() {
    using namespace K; using namespace gd;
    const int tid = otid(), hb = tid >> 8, t = tid & 255, lane = tid & 63, wv = t >> 6, fr = lane & 15, fq = lane >> 4;
    LAS unsigned char* base = (LAS unsigned char*)(dyn_lds + 1024 + hb * 57344);
    LAS float* Ls = (LAS float*)base;
    LAS bf16_t* Tm = (LAS bf16_t*)base;
    LAS float* gam = (LAS float*)(base + 16384);
    LAS float* bet = gam + 64;
    LAS bf16_t* BT = (LAS bf16_t*)(base + 16896);
    LAS float* egd = (LAS float*)(base + 53760);
    LAS float* beg = egd + 64;
    const bf16_t* QKb = uni(PRM.QKb); const float* GB = uni(PRM.GB);
    float* UT = uni(PRM.G_UT); bf16_t* WT = uni(PRM.G_WT); bf16_t* QG = uni(PRM.G_QG); bf16_t* KDT = uni(PRM.G_KDT); bf16_t* AQK = uni(PRM.G_AQK); float* EGL = uni(PRM.G_EGL);
    const int nit = (NCH + ogrid() * 2 - 1) / (ogrid() * 2);
    float gpre = 0.f, bpre = 0.f;
    {   const int cu0 = obid() * 2 + hb; if (cu0 < NCH && t < 64) { const int bh0 = cu0 >> 5, r00 = (bh0 >> 3) * SEQ + (cu0 & 31) * 64; gpre = GB[(size_t)(r00 + t) * 16 + (bh0 & 7)]; bpre = GB[(size_t)(r00 + t) * 16 + 8 + (bh0 & 7)]; } }
    for (int itr = 0; itr < nit; ++itr) {
        const int cu = (itr * ogrid() + obid()) * 2 + hb; const bool on = cu < NCH;
        const int bh = cu >> 5, c = cu & 31, b = bh >> 3, h = bh & 7, row0 = b * SEQ + c * 64;
        lds_barrier();
        if (on && t < 64) {
            float g = gpre;
#pragma unroll
            for (int o = 1; o < 64; o <<= 1) { const float v = __int_as_float(__builtin_amdgcn_ds_bpermute(((lane - o) & 63) << 2, __float_as_int(g))); if (lane >= o) g += v; }
            gam[t] = g; bet[t] = bpre;
            { const float gl = __int_as_float(__builtin_amdgcn_readlane(__float_as_int(g), 63)); egd[t] = __expf(gl - g); beg[t] = bpre * __expf(g); }
        }
        {   const int cun = ((itr + 1) * ogrid() + obid()) * 2 + hb;
            if (itr + 1 < nit && cun < NCH && t < 64) { const int bhn = cun >> 5, rown = (bhn >> 3) * SEQ + (cun & 31) * 64; gpre = GB[(size_t)(rown + t) * 16 + (bhn & 7)]; bpre = GB[(size_t)(rown + t) * 16 + 8 + (bhn & 7)]; } }
        lds_barrier();
        if (on) {
            const bf16_t* qb = QKb + (size_t)row0 * GC + h * 128; const bf16_t* kb = qb + GKW;
            f32x4 G[4], A[4];
#pragma unroll
            for (int nb = 0; nb < 4; ++nb) { G[nb] = (f32x4){0.f, 0.f, 0.f, 0.f}; A[nb] = (f32x4){0.f, 0.f, 0.f, 0.f}; }
            {   pg8::bf16x8 kaf[4], qaf[4], kkf[4][4];
#pragma unroll
                for (int ks = 0; ks < 4; ++ks) { kaf[ks] = *(const pg8::bf16x8*)(kb + (size_t)(16 * wv + fr) * GC + 32 * ks + 8 * fq); qaf[ks] = *(const pg8::bf16x8*)(qb + (size_t)(16 * wv + fr) * GC + 32 * ks + 8 * fq);
#pragma unroll
                    for (int nb = 0; nb < 4; ++nb) kkf[ks][nb] = *(const pg8::bf16x8*)(kb + (size_t)(16 * nb + fr) * GC + 32 * ks + 8 * fq); }
                __builtin_amdgcn_sched_barrier(0);
#pragma unroll
                for (int ks = 0; ks < 4; ++ks)
#pragma unroll
                    for (int nb = 0; nb < 4; ++nb) { G[nb] = __builtin_amdgcn_mfma_f32_16x16x32_bf16(kaf[ks], kkf[ks][nb], G[nb], 0, 0, 0); A[nb] = __builtin_amdgcn_mfma_f32_16x16x32_bf16(qaf[ks], kkf[ks][nb], A[nb], 0, 0, 0); }
                {
                    const float e = __expf(gam[16 * wv + fr]); bf16_t* dst = QG + (size_t)cu * WT_SZ + (16 * wv + fr) * 128 + 8 * fq;
#pragma unroll
                    for (int ks = 0; ks < 4; ++ks) { const u32x4 q4 = *(const u32x4*)&qaf[ks]; u32x4 o;
                        o.x = cvt_pk_bf16(__uint_as_float(q4.x << 16) * e, __uint_as_float(q4.x & 0xffff0000u) * e); o.y = cvt_pk_bf16(__uint_as_float(q4.y << 16) * e, __uint_as_float(q4.y & 0xffff0000u) * e);
                        o.z = cvt_pk_bf16(__uint_as_float(q4.z << 16) * e, __uint_as_float(q4.z & 0xffff0000u) * e); o.w = cvt_pk_bf16(__uint_as_float(q4.w << 16) * e, __uint_as_float(q4.w & 0xffff0000u) * e);
                        *(u32x4*)(dst + 32 * ks) = o; }
                }
            }
            bf16_t* aq = AQK + (size_t)cu * AQ_SZ;
#pragma unroll
            for (int nb = 0; nb < 4; ++nb) { const int j = 16 * nb + fr; const float gj = gam[j];
#pragma unroll
                for (int r = 0; r < 4; ++r) { const int i = 16 * wv + 4 * fq + r; const float dec = __expf(j <= i ? gam[i] - gj : 0.f);
                    Ls[i * 64 + j] = j < i ? bet[i] * G[nb][r] * dec : 0.f;
                    aq[i * 64 + j] = f2bf(j <= i ? A[nb][r] * dec : 0.f); } }
        }
        lds_barrier();
        if (on) {
            { float X[64];
              const bf16_t* src = QKb + (size_t)row0 * GC + (t < 128 ? 2 * GKW + h * 128 + t : GKW + h * 128 + (t - 128));
#pragma unroll
              for (int i = 0; i < 64; ++i) X[i] = __uint_as_float((unsigned)src[(size_t)i * GC] << 16);
              __builtin_amdgcn_sched_barrier(0);
              if (t >= 128) {
                  bf16_t* dst = KDT + (size_t)cu * KDT_SZ + (t - 128) * 64;
#pragma unroll
                  for (int i = 0; i < 64; i += 8) { const f32x4 e0 = *(const LAS f32x4*)(egd + i), e1 = *(const LAS f32x4*)(egd + i + 4); u32x4 o; o.x = cvt_pk_bf16(X[i] * e0[0], X[i + 1] * e0[1]); o.y = cvt_pk_bf16(X[i + 2] * e0[2], X[i + 3] * e0[3]);
                      o.z = cvt_pk_bf16(X[i + 4] * e1[0], X[i + 5] * e1[1]); o.w = cvt_pk_bf16(X[i + 6] * e1[2], X[i + 7] * e1[3]); *(u32x4*)(dst + i) = o; }
              }
#pragma unroll
              for (int i = 0; i < 64; ++i) X[i] *= t < 128 ? bet[i] : beg[i];
#pragma unroll
              for (int i = 0; i < 64; i += 8) { u32x4 w; w.x = cvt_pk_bf16(X[i], X[i + 1]); w.y = cvt_pk_bf16(X[i + 2], X[i + 3]); w.z = cvt_pk_bf16(X[i + 4], X[i + 5]); w.w = cvt_pk_bf16(X[i + 6], X[i + 7]); *(LAS u32x4*)(BT + t * 72 + i) = w; } }
            if (wv == hb) {
                float X[64]; int ln = lane; asm volatile("" : "+v"(ln));
#pragma unroll
                for (int i = 0; i < 64; ++i) X[i] = (i == ln) ? 1.f : 0.f;
#pragma unroll
                for (int i = 1; i < 41; ++i) {
                    f32x4 Lr[10]; float a0 = X[i], a1 = 0.f;
#pragma unroll
                    for (int j4 = 0; j4 < (i + 3) / 4; ++j4) Lr[j4] = *(const LAS f32x4*)(Ls + i * 64 + 4 * j4);
                    __builtin_amdgcn_sched_barrier(0);
#pragma unroll
                    for (int j4 = 0; j4 < (i + 3) / 4; ++j4) { const f32x4 L4 = Lr[j4];
                            if (j4 & 1) { a1 = fmaf(-L4[0], X[4 * j4], a1); if (4 * j4 + 1 < i) a1 = fmaf(-L4[1], X[4 * j4 + 1], a1); if (4 * j4 + 2 < i) a1 = fmaf(-L4[2], X[4 * j4 + 2], a1); if (4 * j4 + 3 < i) a1 = fmaf(-L4[3], X[4 * j4 + 3], a1); }
                            else { a0 = fmaf(-L4[0], X[4 * j4], a0); if (4 * j4 + 1 < i) a0 = fmaf(-L4[1], X[4 * j4 + 1], a0); if (4 * j4 + 2 < i) a0 = fmaf(-L4[2], X[4 * j4 + 2], a0); if (4 * j4 + 3 < i) a0 = fmaf(-L4[3], X[4 * j4 + 3], a0); } }
                    X[i] = a0 + a1;
                    __builtin_amdgcn_sched_barrier(0);
                }
#pragma unroll
                for (int i = 41; i < 64; ++i) {
                    f32x4 Lr[10], Lq[6]; float a0 = X[i], a1 = 0.f;
#pragma unroll
                    for (int j4 = 0; j4 < 10; ++j4) Lr[j4] = *(const LAS f32x4*)(Ls + i * 64 + 4 * j4);
                    __builtin_amdgcn_sched_barrier(0);
#pragma unroll
                    for (int j4 = 0; j4 < 10; ++j4) { const f32x4 L4 = Lr[j4];
                            if (j4 & 1) { a1 = fmaf(-L4[0], X[4 * j4], a1); if (4 * j4 + 1 < i) a1 = fmaf(-L4[1], X[4 * j4 + 1], a1); if (4 * j4 + 2 < i) a1 = fmaf(-L4[2], X[4 * j4 + 2], a1); if (4 * j4 + 3 < i) a1 = fmaf(-L4[3], X[4 * j4 + 3], a1); }
                            else { a0 = fmaf(-L4[0], X[4 * j4], a0); if (4 * j4 + 1 < i) a0 = fmaf(-L4[1], X[4 * j4 + 1], a0); if (4 * j4 + 2 < i) a0 = fmaf(-L4[2], X[4 * j4 + 2], a0); if (4 * j4 + 3 < i) a0 = fmaf(-L4[3], X[4 * j4 + 3], a0); } }
#pragma unroll
                    for (int j4 = 10; j4 < (i + 3) / 4; ++j4) Lq[j4 - 10] = *(const LAS f32x4*)(Ls + i * 64 + 4 * j4);
                    __builtin_amdgcn_sched_barrier(0);
#pragma unroll
                    for (int j4 = 10; j4 < (i + 3) / 4; ++j4) { const f32x4 L4 = Lq[j4 - 10];
                            if (j4 & 1) { a1 = fmaf(-L4[0], X[4 * j4], a1); if (4 * j4 + 1 < i) a1 = fmaf(-L4[1], X[4 * j4 + 1], a1); if (4 * j4 + 2 < i) a1 = fmaf(-L4[2], X[4 * j4 + 2], a1); if (4 * j4 + 3 < i) a1 = fmaf(-L4[3], X[4 * j4 + 3], a1); }
                            else { a0 = fmaf(-L4[0], X[4 * j4], a0); if (4 * j4 + 1 < i) a0 = fmaf(-L4[1], X[4 * j4 + 1], a0); if (4 * j4 + 2 < i) a0 = fmaf(-L4[2], X[4 * j4 + 2], a0); if (4 * j4 + 3 < i) a0 = fmaf(-L4[3], X[4 * j4 + 3], a0); } }
                    X[i] = a0 + a1;
                    __builtin_amdgcn_sched_barrier(0);
                }
                asm volatile("s_waitcnt lgkmcnt(0)" ::: "memory");
#pragma unroll
                for (int i = 0; i < 64; ++i) Tm[i * 72 + ln] = f2bf(X[i]);
            }
        }
        lds_barrier();
        if (on) {
            pg8::bf16x8 tf[4][2];
#pragma unroll
            for (int tb = 0; tb < 4; ++tb)
#pragma unroll
                for (int ks = 0; ks < 2; ++ks) tf[tb][ks] = *(const LAS pg8::bf16x8*)(Tm + (16 * tb + fr) * 72 + 32 * ks + 8 * fq);
#pragma unroll
            for (int cb4 = 0; cb4 < 4; ++cb4) {
                const int colb = 64 * wv + 16 * cb4;
                const pg8::bf16x8 b0 = *(const LAS pg8::bf16x8*)(BT + (colb + fr) * 72 + 8 * fq), b1 = *(const LAS pg8::bf16x8*)(BT + (colb + fr) * 72 + 32 + 8 * fq);
#pragma unroll
                for (int tb = 0; tb < 4; ++tb) {
                    f32x4 d = {0.f, 0.f, 0.f, 0.f};
                    d = __builtin_amdgcn_mfma_f32_16x16x32_bf16(b0, tf[tb][0], d, 0, 0, 0); d = __builtin_amdgcn_mfma_f32_16x16x32_bf16(b1, tf[tb][1], d, 0, 0, 0);
                    if (colb < 128) { float* up = UT + (size_t)cu * UT_SZ + (size_t)(colb + 4 * fq) * 64 + 16 * tb + fr;
#pragma unroll
                        for (int r = 0; r < 4; ++r) up[r * 64] = d[r]; }
                    else { u32x2 w; w.x = cvt_pk_bf16(d[0], d[1]); w.y = cvt_pk_bf16(d[2], d[3]); *(u32x2*)(WT + (size_t)cu * WT_SZ + (size_t)(16 * tb + fr) * 128 + (colb - 128) + 4 * fq) = w; }
                }
            }
            if (t == 0) EGL[cu] = __expf(gam[63]);
        }
    }
    __syncthreads();
}
NOINL void ph_gdn_seq(int layer, int u0, int ust) {
    using namespace K; using namespace gd;
    const int tid = otid(), lane = tid & 63, w = tid >> 6, fr = lane & 15, fq = lane >> 4;
    LAS unsigned char* lds = (LAS unsigned char*)(dyn_lds + 1024);
    const float* UT = uni(PRM.G_UT); const bf16_t* WT = uni(PRM.G_WT); const bf16_t* QG = uni(PRM.G_QG); const bf16_t* KDT = uni(PRM.G_KDT); const bf16_t* AQK = uni(PRM.G_AQK); const float* EGL = uni(PRM.G_EGL);
    float* OG = uni(PRM.OG); float* out = uni(PRM.out);
    for (int bh = u0; bh < BP * GH; bh += ust) {
        const int b = bh >> 3, h = bh & 7;
        f32x4 S[8];
#pragma unroll
        for (int mb = 0; mb < 8; ++mb) S[mb] = (f32x4){0.f, 0.f, 0.f, 0.f};
        u32x4 st[7];
        auto gload = [&](int cu) {
#pragma unroll
            for (int k = 0; k < 7; ++k) { const int pc = tid + 512 * k;
                const bf16_t* src = pc < 1024 ? WT + (size_t)cu * WT_SZ + pc * 8 : pc < 2048 ? QG + (size_t)cu * WT_SZ + (pc - 1024) * 8 : pc < 3072 ? KDT + (size_t)cu * KDT_SZ + (pc - 2048) * 8 : AQK + (size_t)cu * AQ_SZ + (pc - 3072) * 8;
                st[k] = *(const u32x4*)src; } };
        auto lstore = [&](int buf) {
#pragma unroll
            for (int k = 0; k < 7; ++k) { const int pc = tid + 512 * k; int off;
                if (pc < 1024) off = B_WT + (pc >> 4) * WROW + (pc & 15) * 16; else if (pc < 2048) off = B_QG + ((pc - 1024) >> 4) * WROW + (pc & 15) * 16;
                else if (pc < 3072) off = B_KD + ((pc - 2048) >> 3) * KROW + (pc & 7) * 16; else off = B_AQ + ((pc - 3072) >> 3) * AROW + (pc & 7) * 16;
                *(LAS u32x4*)(lds + buf * BUFSZ + off) = st[k]; } };
        const int cu0 = bh * 32;
        gload(cu0);
        __syncthreads();
        lstore(0);
        f32x4 ut[4];
#pragma unroll
        for (int tb = 0; tb < 4; ++tb) ut[tb] = *(const f32x4*)(UT + (size_t)cu0 * UT_SZ + (16 * w + fr) * 64 + 16 * tb + 4 * fq);
        float egl = EGL[cu0];
        __syncthreads();
        for (int c = 0; c < 32; ++c) {
            const int cu = cu0 + c, bo = (c & 1) * BUFSZ; const bool more = c + 1 < 32;
            if (more) gload(cu + 1);
            pg8::bf16x8 Sb[4];
#pragma unroll
            for (int ks = 0; ks < 4; ++ks) { u32x4 x; x.x = cvt_pk_bf16(S[2 * ks][0], S[2 * ks][1]); x.y = cvt_pk_bf16(S[2 * ks][2], S[2 * ks][3]); x.z = cvt_pk_bf16(S[2 * ks + 1][0], S[2 * ks + 1][1]); x.w = cvt_pk_bf16(S[2 * ks + 1][2], S[2 * ks + 1][3]); Sb[ks] = *(pg8::bf16x8*)&x; }
            f32x4 Uc[4], Oc[4];
#pragma unroll
            for (int tb = 0; tb < 4; ++tb) {
                u32x2 wf[4][2], qf2[4][2];
#pragma unroll
                for (int ks = 0; ks < 4; ++ks) {
                    const LAS unsigned char* wp = lds + bo + B_WT + (16 * tb + fr) * WROW + (32 * ks + 4 * fq) * 2; const LAS unsigned char* qp = lds + bo + B_QG + (16 * tb + fr) * WROW + (32 * ks + 4 * fq) * 2;
                    wf[ks][0] = *(const LAS u32x2*)wp; wf[ks][1] = *(const LAS u32x2*)(wp + 32); qf2[ks][0] = *(const LAS u32x2*)qp; qf2[ks][1] = *(const LAS u32x2*)(qp + 32); }
                __builtin_amdgcn_sched_barrier(0);
                f32x4 p = {0.f, 0.f, 0.f, 0.f}, o = {0.f, 0.f, 0.f, 0.f};
#pragma unroll
                for (int ks = 0; ks < 4; ++ks) {
                    u32x4 wa = {wf[ks][0].x, wf[ks][0].y, wf[ks][1].x, wf[ks][1].y}, qa = {qf2[ks][0].x, qf2[ks][0].y, qf2[ks][1].x, qf2[ks][1].y};
                    p = __builtin_amdgcn_mfma_f32_16x16x32_bf16(*(pg8::bf16x8*)&wa, Sb[ks], p, 0, 0, 0);
                    o = __builtin_amdgcn_mfma_f32_16x16x32_bf16(*(pg8::bf16x8*)&qa, Sb[ks], o, 0, 0, 0);
                }
                Uc[tb] = ut[tb] - p; Oc[tb] = o;
                __builtin_amdgcn_sched_barrier(0);
            }
            if (more) {
#pragma unroll
                for (int tb = 0; tb < 4; ++tb) ut[tb] = *(const f32x4*)(UT + (size_t)(cu + 1) * UT_SZ + (16 * w + fr) * 64 + 16 * tb + 4 * fq);
            }
            pg8::bf16x8 Ub[2];
#pragma unroll
            for (int s2 = 0; s2 < 2; ++s2) { u32x4 x; x.x = cvt_pk_bf16(Uc[2 * s2][0], Uc[2 * s2][1]); x.y = cvt_pk_bf16(Uc[2 * s2][2], Uc[2 * s2][3]); x.z = cvt_pk_bf16(Uc[2 * s2 + 1][0], Uc[2 * s2 + 1][1]); x.w = cvt_pk_bf16(Uc[2 * s2 + 1][2], Uc[2 * s2 + 1][3]); Ub[s2] = *(pg8::bf16x8*)&x; }
            u32x2 af[4][2][2];
#pragma unroll
            for (int tb = 0; tb < 4; ++tb)
#pragma unroll
                for (int s2 = 0; s2 < 2; ++s2) { const LAS unsigned char* ap = lds + bo + B_AQ + (16 * tb + fr) * AROW + (32 * s2 + 4 * fq) * 2; af[tb][s2][0] = *(const LAS u32x2*)ap; af[tb][s2][1] = *(const LAS u32x2*)(ap + 32); }
            __builtin_amdgcn_sched_barrier(0);
#pragma unroll
            for (int tb = 0; tb < 4; ++tb) {
#pragma unroll
                for (int s2 = 0; s2 < 2; ++s2) { u32x4 aa = {af[tb][s2][0].x, af[tb][s2][0].y, af[tb][s2][1].x, af[tb][s2][1].y};
                    Oc[tb] = __builtin_amdgcn_mfma_f32_16x16x32_bf16(*(pg8::bf16x8*)&aa, Ub[s2], Oc[tb], 0, 0, 0); }
                bf16_t* op = (bf16_t*)OG + (size_t)(b * SEQ + c * 64 + 16 * tb + 4 * fq) * GVW + h * 128 + 16 * w + fr;
#pragma unroll
                for (int r = 0; r < 4; ++r) op[(size_t)r * GVW] = f2bf(Oc[tb][r]);
            }
#pragma unroll
            for (int mh = 0; mh < 2; ++mh) {
                u32x2 kf[4][2][2];
#pragma unroll
                for (int m4 = 0; m4 < 4; ++m4)
#pragma unroll
                    for (int s2 = 0; s2 < 2; ++s2) { const LAS unsigned char* kp = lds + bo + B_KD + (16 * (4 * mh + m4) + fr) * KROW + (32 * s2 + 4 * fq) * 2; kf[m4][s2][0] = *(const LAS u32x2*)kp; kf[m4][s2][1] = *(const LAS u32x2*)(kp + 32); }
                __builtin_amdgcn_sched_barrier(0);
#pragma unroll
                for (int m4 = 0; m4 < 4; ++m4) { const int mb = 4 * mh + m4;
                    f32x4 sacc = S[mb] * egl;
#pragma unroll
                    for (int s2 = 0; s2 < 2; ++s2) { u32x4 ka = {kf[m4][s2][0].x, kf[m4][s2][0].y, kf[m4][s2][1].x, kf[m4][s2][1].y};
                        sacc = __builtin_amdgcn_mfma_f32_16x16x32_bf16(*(pg8::bf16x8*)&ka, Ub[s2], sacc, 0, 0, 0); }
                    S[mb] = sacc; }
                __builtin_amdgcn_sched_barrier(0);
            }
            if (more) { lstore((c + 1) & 1); egl = EGL[cu + 1]; }
            __syncthreads();
        }
        float* so = out + O_GSP + ((size_t)(layer * BP + b) * GH + h) * GDK * GDV + 16 * w + fr;
#pragma unroll
        for (int mb = 0; mb < 8; ++mb)
#pragma unroll
            for (int r = 0; r < 4; ++r) so[(size_t)(16 * mb + 4 * fq + r) * GDV] = S[mb][r];
    }
    __syncthreads();
}

#define GIDS const int tid = otid(), lane = tid & 63, wid = tid >> 6, bid_ = obid(), grid_ = ogrid(); (void)lane; (void)wid; \
    const size_t gtid = (size_t)bid_ * 512 + tid, gthreads = (size_t)grid_ * 512; (void)gtid; (void)gthreads; \
    const int gwave = bid_ * 8 + wid, gwaves = grid_ * 8; (void)gwave; (void)gwaves;

NOINL void ph_init() {
    using namespace K; GIDS
    const float* cp = uni(PRM.c_prompt); const float* cs = uni(PRM.c_sample); float* csilu = uni(PRM.csilu);
    for (size_t i = gtid; i < (size_t)NC * D; i += gthreads) {
        const int cb = (int)(i / D), k = (int)(i % D);
        const float c = cb < BP ? cp[(size_t)cb * D + k] : cs[(size_t)(cb - BP) * D + k];
        csilu[i] = silu_f(c);
    }
    { float* SPL = uni(PRM.SPL); const float* lam = uni(PRM.rg_lambda); for (size_t i = gtid; i < (size_t)DEPTH * DRNN; i += gthreads) SPL[i] = -8.0f * softplus_f(-lam[i]); }
    float* ROT = uni(PRM.ROT);
    for (size_t i = gtid; i < (size_t)(SEQ + 1) * 16; i += gthreads) {
        const int ps = (int)(i >> 4), ii = (int)(i & 15);
        const float ang = (ps < SEQ ? (float)ps : (float)PAST) * rope_inv(ii);
        ROT[2 * i] = (float)cos((double)ang); ROT[2 * i + 1] = (float)sin((double)ang);
    }
}
NOINL void ph_mod_all() {
    using namespace K;
    const int tid = otid(), cn = tid & 63, ks = tid >> 6;
    LAS float* csl = (LAS float*)(dyn_lds + 1024);
    const float* cs = uni(PRM.csilu);
    for (int u = obid(); u < DEPTH * 96; u += ogrid()) {
        const int l = u / 96, n0 = (u % 96) * 64, n = n0 + cn;
        const float* W = uni(PRM.w_ada) + (size_t)l * D * 6 * D; const float* bl = uni(PRM.b_ada) + (size_t)l * 6 * D; float* modl = uni(PRM.mod) + (size_t)l * NC * 6 * D;
        float acc[NC];
#pragma unroll
        for (int c = 0; c < NC; ++c) acc[c] = 0.f;
        for (int half = 0; half < 2; ++half) {
            __syncthreads();
            for (int i = tid; i < NC * 512; i += 512) { const int c = i >> 9, j = i & 511; csl[i] = cs[c * D + half * 512 + j]; }
            __syncthreads();
            const float* wp = W + (size_t)(half * 512 + ks * 64) * 6 * D + n;
#pragma unroll 8
            for (int kk = 0; kk < 64; kk += 4) {
                const float w0 = wp[(size_t)kk * 6 * D], w1 = wp[(size_t)(kk + 1) * 6 * D], w2 = wp[(size_t)(kk + 2) * 6 * D], w3 = wp[(size_t)(kk + 3) * 6 * D];
#pragma unroll
                for (int c = 0; c < NC; ++c) { const f32x4 c4 = *(const LAS f32x4*)(csl + c * 512 + ks * 64 + kk);
                    acc[c] = fmaf(c4[0], w0, acc[c]); acc[c] = fmaf(c4[1], w1, acc[c]); acc[c] = fmaf(c4[2], w2, acc[c]); acc[c] = fmaf(c4[3], w3, acc[c]); }
            }
        }
        __syncthreads();
#pragma unroll
        for (int c = 0; c < NC; ++c) csl[(ks * NC + c) * 64 + cn] = acc[c];
        __syncthreads();
        for (int i = tid; i < NC * 64; i += 512) { const int c = i >> 6, j = i & 63; float t = bl[n0 + j];
#pragma unroll
            for (int k2 = 0; k2 < 8; ++k2) t += csl[(k2 * NC + c) * 64 + j];
            modl[(size_t)c * 6 * D + n0 + j] = t; }
    }
    __syncthreads();
}
NOINL void ph_norm(int l, int which) {
    using namespace K; GIDS
    const bool inp = which == 0 && l == 0;
    const float* x = which == 0 ? (l == 0 ? uni(PRM.x_prompt) : uni(PRM.X2)) : uni(PRM.X1); const float* xsm = inp ? uni(PRM.x_sample) - (size_t)NP * D : x; const float* g = (which == 0 ? uni(PRM.g_norm1) : uni(PRM.g_norm2)) + (size_t)l * D; const float* modl = uni(PRM.mod) + (size_t)l * NC * 6 * D;
    bf16_t* HA = uni(PRM.HA);
    float4 gv[4];
#pragma unroll
    for (int i = 0; i < 4; ++i) gv[i] = *(const float4*)(g + i * 256 + lane * 4);
    float4 xn[2][4];
    auto ldx = [&](int rowA) {
#pragma unroll
        for (int k = 0; k < 2; ++k) { const int row = rowA + k * gwaves < R ? rowA + k * gwaves : rowA;
            if (inp) { const float* xr = (row < NP ? x : xsm) + (size_t)row * D;
#pragma unroll
                for (int i = 0; i < 4; ++i) xn[k][i] = *(const float4*)(xr + i * 256 + lane * 4); }
            else { const bf16_t* xr = (const bf16_t*)x + (size_t)row * D;
#pragma unroll
                for (int i = 0; i < 4; ++i) { const u32x2 w = *(const u32x2*)(xr + i * 256 + lane * 4); xn[k][i] = make_float4(__uint_as_float(w.x), __uint_as_float(w.y), 0.f, 0.f); } } } };
    auto xval = [&](float4 t) { if (!inp) { const unsigned a = __float_as_uint(t.x), b = __float_as_uint(t.y); t = make_float4(__uint_as_float(a << 16), __uint_as_float(a & 0xffff0000u), __uint_as_float(b << 16), __uint_as_float(b & 0xffff0000u)); } return t; };
    if (gwave < R) ldx(gwave);
    for (int rowA = gwave; rowA < R; rowA += 2 * gwaves) {
        float4 xv[2][4], scv[2][4], shv[2][4];
#pragma unroll
        for (int k = 0; k < 2; ++k) { const int row = rowA + k * gwaves < R ? rowA + k * gwaves : rowA; const float* md = modl + (size_t)cond_of_row(row) * 6 * D + which * 3 * D;
#pragma unroll
            for (int i = 0; i < 4; ++i) { const int c = i * 256 + lane * 4; xv[k][i] = xn[k][i]; scv[k][i] = *(const float4*)(md + D + c); shv[k][i] = *(const float4*)(md + c); } }
        if (rowA + 2 * gwaves < R) ldx(rowA + 2 * gwaves);
        __builtin_amdgcn_sched_barrier(0);
#pragma unroll
        for (int k = 0; k < 2; ++k) { const int row = rowA + k * gwaves; if (row < R) {
            float ss = 0.f;
#pragma unroll
            for (int i = 0; i < 4; ++i) { const float4 t = xval(xv[k][i]); ss += t.x * t.x + t.y * t.y + t.z * t.z + t.w * t.w; }
            ss = wave_sum(ss, lane); const float rs = rsqrtf(ss * (1.0f / D) + EPS);
#pragma unroll
            for (int i = 0; i < 4; ++i) { const float4 t = xval(xv[k][i]);
                const float o0 = t.x * rs * gv[i].x * (1.0f + scv[k][i].x) + shv[k][i].x, o1 = t.y * rs * gv[i].y * (1.0f + scv[k][i].y) + shv[k][i].y;
                const float o2 = t.z * rs * gv[i].z * (1.0f + scv[k][i].z) + shv[k][i].z, o3 = t.w * rs * gv[i].w * (1.0f + scv[k][i].w) + shv[k][i].w;
                u32x2 w; w.x = cvt_pk_bf16(o0, o1); w.y = cvt_pk_bf16(o2, o3); *(u32x2*)(HA + (size_t)row * D + i * 256 + lane * 4) = w; } } }
    }
}
NOINL void ph_gemm_u(int l) {
    using namespace K;
    const EpiU E{uni(PRM.URX), uni(PRM.GY), uni(PRM.UQKV), uni(PRM.SZ), uni(PRM.R1), uni(PRM.R2), uni(PRM.R3), uni(PRM.USM)}; const bf16_t* W = uni(PRM.WIN) + (size_t)l * WIN_SZ; const bf16_t* A = uni(PRM.HA);
    pg8::StaticOrder S; S.init(NP, NINP, ogrid(), obid());
    pg8::gemm_phase(GEMM_LDS, A, D, W, D, S, E);
    pg8::gemm_skinny<8>(A + (size_t)NP * D, D, W, NINP, D, NP, 64, E, 192);
}
DEVI float bf2f(bf16_t v) { return __uint_as_float((unsigned)v << 16); }
NOINL void ph_rg_state_copies(int l) {
    using namespace K; GIDS
    const bf16_t* URX = uni(PRM.URX); float* out = uni(PRM.out); const float* strg = uni(PRM.state_rg_conv);
    for (size_t i = gtid; i < (size_t)BP * 3 * DRNN; i += gthreads) { const int c = (int)(i % DRNN), j = (int)((i / DRNN) % 3), b = (int)(i / (3 * DRNN));
        out[O_RGCP + (size_t)l * BP * 3 * DRNN + i] = bf2f(URX[(size_t)(b * SEQ + SEQ - 3 + j) * DRNN + c]); }
    for (size_t i = gtid; i < (size_t)BS * 3 * DRNN; i += gthreads) { const int c = (int)(i % DRNN), j = (int)((i / DRNN) % 3), sb = (int)(i / (3 * DRNN));
        out[O_RGCS + (size_t)l * BS * 3 * DRNN + i] = j < 2 ? strg[((size_t)(l * BS + sb) * 3 + j + 1) * DRNN + c] : bf2f(URX[(size_t)(NP + sb) * DRNN + c]); }
}
NOINL void ph_rg_sample(int l, int vb, int vgrid) {
    using namespace K;
    const int tid = otid(), bid_ = vb, grid_ = vgrid; const size_t gtid = (size_t)bid_ * 512 + tid, gthreads = (size_t)grid_ * 512;
    const bf16_t* URX = uni(PRM.URX); const bf16_t* GY = uni(PRM.GY); float* XC = uni(PRM.XC); float* out = uni(PRM.out); const float* strg = uni(PRM.state_rg_conv); bf16_t* CAT = uni(PRM.CAT);
    const float* cw = uni(PRM.rg_conv_w) + (size_t)l * 4 * DRNN; const float* cbias = uni(PRM.rg_conv_b) + (size_t)l * DRNN;
    const float* wa = uni(PRM.rg_wa) + (size_t)l * RGN * RGB * RGB; const float* wx = uni(PRM.rg_wx) + (size_t)l * RGN * RGB * RGB;
    const float* ba = uni(PRM.rg_ba) + (size_t)l * DRNN; const float* bx = uni(PRM.rg_bx) + (size_t)l * DRNN; const float* spl = uni(PRM.SPL) + (size_t)l * DRNN; const float* sth = uni(PRM.state_rg_h) + (size_t)l * BS * DRNN;
    LAS float* xs = (LAS float*)(dyn_lds + 1024);
    const int grp = tid >> 7, cl = tid & 127;
    for (int g0 = bid_ * 4; g0 < BS * RGN; g0 += grid_ * 4) {
        const int g = g0 + grp; const bool on = g < BS * RGN; const int sb = on ? g / RGN : 0, n = on ? g % RGN : 0, c = n * RGB + cl, row = NP + sb;
        float xc = 0.f;
        if (on) { const float* st = strg + ((size_t)(l * BS + sb) * 3) * DRNN; xc = cbias[c];
#pragma unroll
            for (int j = 0; j < 3; ++j) xc = fmaf(cw[j * DRNN + c], st[j * DRNN + c], xc);
            xc = fmaf(cw[3 * DRNN + c], bf2f(URX[(size_t)row * DRNN + c]), xc); }
        __syncthreads();
        xs[grp * 128 + cl] = xc;
        __syncthreads();
        if (on) {
            float gr = ba[c], gi = bx[c];
            const bf16_t* wr = uni(PRM.WRG) + ((size_t)l * RGN + n) * 256 * 128 + (size_t)cl * 128; const bf16_t* wi = wr + 128 * 128;
#pragma unroll
            for (int hb = 0; hb < 2; ++hb) {
                u32x4 wa8[8], wx8[8];
#pragma unroll
                for (int q = 0; q < 8; ++q) { wa8[q] = *(const u32x4*)(wr + 64 * hb + 8 * q); wx8[q] = *(const u32x4*)(wi + 64 * hb + 8 * q); }
                __builtin_amdgcn_sched_barrier(0);
#pragma unroll
                for (int q = 0; q < 8; ++q) { const f32x4 x0 = *(const LAS f32x4*)(xs + grp * 128 + 64 * hb + 8 * q), x1 = *(const LAS f32x4*)(xs + grp * 128 + 64 * hb + 8 * q + 4);
                    const u32x4 a = wa8[q], b = wx8[q];
                    gr = fmaf(x0[0], __uint_as_float(a.x << 16), gr); gr = fmaf(x0[1], __uint_as_float(a.x & 0xffff0000u), gr); gr = fmaf(x0[2], __uint_as_float(a.y << 16), gr); gr = fmaf(x0[3], __uint_as_float(a.y & 0xffff0000u), gr);
                    gr = fmaf(x1[0], __uint_as_float(a.z << 16), gr); gr = fmaf(x1[1], __uint_as_float(a.z & 0xffff0000u), gr); gr = fmaf(x1[2], __uint_as_float(a.w << 16), gr); gr = fmaf(x1[3], __uint_as_float(a.w & 0xffff0000u), gr);
                    gi = fmaf(x0[0], __uint_as_float(b.x << 16), gi); gi = fmaf(x0[1], __uint_as_float(b.x & 0xffff0000u), gi); gi = fmaf(x0[2], __uint_as_float(b.y << 16), gi); gi = fmaf(x0[3], __uint_as_float(b.y & 0xffff0000u), gi);
                    gi = fmaf(x1[0], __uint_as_float(b.z << 16), gi); gi = fmaf(x1[1], __uint_as_float(b.z & 0xffff0000u), gi); gi = fmaf(x1[2], __uint_as_float(b.w << 16), gi); gi = fmaf(x1[3], __uint_as_float(b.w & 0xffff0000u), gi); }
                __builtin_amdgcn_sched_barrier(0);
            }
            const float r = fast_sigmoid(gr), ii = fast_sigmoid(gi), la = r * spl[c], a = __expf(la), bm = sqrtf(neg_expm1_small(2.0f * la));
            const float h = a * sth[(size_t)sb * DRNN + c] + bm * (ii * xc);
            CAT[(size_t)row * CATW + CAT_RG + c] = f2bf(h * fast_gelu_tanh(bf2f(GY[(size_t)row * DRNN + c])));
            out[O_RGHS + ((size_t)l * BS + sb) * DRNN + c] = h;
        }
    }
    __syncthreads();
}
NOINL void ph_tok_gdn(int l) {
    using namespace K; GIDS
    const bf16_t* UQ = uni(PRM.UQKV); const float* USM = uni(PRM.USM); float* QKVC = uni(PRM.QKVC); float* GB = uni(PRM.GB); float* out = uni(PRM.out); const float* stg = uni(PRM.state_gdn_conv); bf16_t* QKb = uni(PRM.QKb);
    const float* cw = uni(PRM.gdn_conv_w) + (size_t)l * 4 * GC; const float* Alog = uni(PRM.gdn_A_log) + l * GH; const float* dtb = uni(PRM.gdn_dt_bias) + l * GH;
    {
        const size_t gth = (gthreads / 384) * 384, nit = gtid < gth ? (size_t)(NP / 8) * 384 : 0;
        const int cg = (int)(gtid % 384), c0 = cg * 8, slot = cg >> 4;
        float4 wv0[4], wv1[4];
#pragma unroll
        for (int j = 0; j < 4; ++j) { wv0[j] = *(const float4*)(cw + (size_t)j * GC + c0); wv1[j] = *(const float4*)(cw + (size_t)j * GC + c0 + 4); }
        u32x4 xn[11];
        if (gtid < nit) { const int row0 = (int)(gtid / 384) * 8, t0 = row0 & (SEQ - 1);
#pragma unroll
            for (int i = 0; i < 11; ++i) xn[i] = (t0 - 3 + i) >= 0 ? *(const u32x4*)(UQ + (size_t)(row0 - 3 + i) * GC + c0) : (u32x4){0u, 0u, 0u, 0u}; }
        for (size_t it = gtid; it < nit; it += gth) {
            const int row0 = (int)(it / 384) * 8;
            u32x4 xr[11];
#pragma unroll
            for (int i = 0; i < 11; ++i) xr[i] = xn[i];
            if (it + gth < nit) { const int rown = (int)((it + gth) / 384) * 8, tn = rown & (SEQ - 1);
#pragma unroll
                for (int i = 0; i < 11; ++i) xn[i] = (tn - 3 + i) >= 0 ? *(const u32x4*)(UQ + (size_t)(rown - 3 + i) * GC + c0) : (u32x4){0u, 0u, 0u, 0u}; }
            __builtin_amdgcn_sched_barrier(0);
#pragma unroll
            for (int o = 0; o < 8; ++o) {
                float a[8];
#pragma unroll
                for (int e = 0; e < 8; ++e) a[e] = 0.f;
#pragma unroll
                for (int j = 0; j < 4; ++j) { const u32x4 w = xr[o + j]; const float4 w0 = wv0[j], w1 = wv1[j];
                    a[0] = fmaf(w0.x, __uint_as_float(w.x << 16), a[0]); a[1] = fmaf(w0.y, __uint_as_float(w.x & 0xffff0000u), a[1]); a[2] = fmaf(w0.z, __uint_as_float(w.y << 16), a[2]); a[3] = fmaf(w0.w, __uint_as_float(w.y & 0xffff0000u), a[3]);
                    a[4] = fmaf(w1.x, __uint_as_float(w.z << 16), a[4]); a[5] = fmaf(w1.y, __uint_as_float(w.z & 0xffff0000u), a[5]); a[6] = fmaf(w1.z, __uint_as_float(w.w << 16), a[6]); a[7] = fmaf(w1.w, __uint_as_float(w.w & 0xffff0000u), a[7]); }
                float ss = 0.f;
#pragma unroll
                for (int e = 0; e < 8; ++e) { a[e] = a[e] * fast_sigmoid(a[e]); ss += a[e] * a[e]; }
                ss = row16_sum(ss);
                if (slot < 16) { const float sc = rsqrtf(ss + EPS) * (slot < 8 ? 0.08838834764831845f : 1.0f);
#pragma unroll
                    for (int e = 0; e < 8; ++e) a[e] *= sc; }
                u32x4 w; w.x = cvt_pk_bf16(a[0], a[1]); w.y = cvt_pk_bf16(a[2], a[3]); w.z = cvt_pk_bf16(a[4], a[5]); w.w = cvt_pk_bf16(a[6], a[7]); *(u32x4*)(QKb + (size_t)(row0 + o) * GC + c0) = w;
            }
        }
    }
    for (size_t it = gtid; it < (size_t)BS * 384; it += gthreads) {
        const int row = NP + (int)(it / 384), cg = (int)(it % 384), c0 = cg * 8, slot = cg >> 4;
        float a[8];
#pragma unroll
        for (int e = 0; e < 8; ++e) a[e] = 0.f;
        u32x4 xr[4]; float4 xs0[3], xs1[3], wv0[4], wv1[4]; bool have[4];
#pragma unroll
        for (int j = 0; j < 4; ++j) {
            have[j] = row >= NP || ((row & (SEQ - 1)) - 3 + j) >= 0;
            wv0[j] = *(const float4*)(cw + (size_t)j * GC + c0); wv1[j] = *(const float4*)(cw + (size_t)j * GC + c0 + 4);
            if (row < NP) { xr[j] = have[j] ? *(const u32x4*)(UQ + (size_t)(row - 3 + j) * GC + c0) : (u32x4){0u, 0u, 0u, 0u}; }
            else if (j < 3) { const float* st = stg + ((size_t)(l * BS + (row - NP)) * 3 + j) * GC + c0; xs0[j] = *(const float4*)st; xs1[j] = *(const float4*)(st + 4); }
            else xr[j] = *(const u32x4*)(UQ + (size_t)row * GC + c0);
        }
        __builtin_amdgcn_sched_barrier(0);
#pragma unroll
        for (int j = 0; j < 4; ++j) {
            float x[8];
            if (row >= NP && j < 3) { x[0] = xs0[j].x; x[1] = xs0[j].y; x[2] = xs0[j].z; x[3] = xs0[j].w; x[4] = xs1[j].x; x[5] = xs1[j].y; x[6] = xs1[j].z; x[7] = xs1[j].w; }
            else { const u32x4 w = xr[j];
                x[0] = __uint_as_float(w.x << 16); x[1] = __uint_as_float(w.x & 0xffff0000u); x[2] = __uint_as_float(w.y << 16); x[3] = __uint_as_float(w.y & 0xffff0000u);
                x[4] = __uint_as_float(w.z << 16); x[5] = __uint_as_float(w.z & 0xffff0000u); x[6] = __uint_as_float(w.w << 16); x[7] = __uint_as_float(w.w & 0xffff0000u); }
            if (have[j]) { const float4 w0 = wv0[j], w1 = wv1[j];
                a[0] = fmaf(w0.x, x[0], a[0]); a[1] = fmaf(w0.y, x[1], a[1]); a[2] = fmaf(w0.z, x[2], a[2]); a[3] = fmaf(w0.w, x[3], a[3]);
                a[4] = fmaf(w1.x, x[4], a[4]); a[5] = fmaf(w1.y, x[5], a[5]); a[6] = fmaf(w1.z, x[6], a[6]); a[7] = fmaf(w1.w, x[7], a[7]); }
        }
        float ss = 0.f;
#pragma unroll
        for (int e = 0; e < 8; ++e) { a[e] = a[e] * fast_sigmoid(a[e]); ss += a[e] * a[e]; }
        ss += shx(ss, 1, lane); ss += shx(ss, 2, lane); ss += shx(ss, 4, lane); ss += shx(ss, 8, lane);
        if (slot < 16) { const float sc = rsqrtf(ss + EPS) * (slot < 8 ? 0.08838834764831845f : 1.0f);
#pragma unroll
            for (int e = 0; e < 8; ++e) a[e] *= sc; }
        if (row < NP) { u32x4 w; w.x = cvt_pk_bf16(a[0], a[1]); w.y = cvt_pk_bf16(a[2], a[3]); w.z = cvt_pk_bf16(a[4], a[5]); w.w = cvt_pk_bf16(a[6], a[7]); *(u32x4*)(QKb + (size_t)row * GC + c0) = w; }
        else { float* q = QKVC + (size_t)row * GC + c0; *(float4*)q = make_float4(a[0], a[1], a[2], a[3]); *(float4*)(q + 4) = make_float4(a[4], a[5], a[6], a[7]); }
    }
    for (size_t i = gtid; i < (size_t)BP * 3 * GC; i += gthreads) { const int c = (int)(i % GC), j = (int)((i / GC) % 3), b = (int)(i / (3 * GC));
        out[O_GCP + (size_t)l * BP * 3 * GC + i] = bf2f(UQ[(size_t)(b * SEQ + SEQ - 3 + j) * GC + c]); }
    for (size_t i = gtid; i < (size_t)BS * 3 * GC; i += gthreads) { const int c = (int)(i % GC), j = (int)((i / GC) % 3), sb = (int)(i / (3 * GC));
        out[O_GCS + (size_t)l * BS * 3 * GC + i] = j < 2 ? stg[((size_t)(l * BS + sb) * 3 + j + 1) * GC + c] : bf2f(UQ[(size_t)(NP + sb) * GC + c]); }
    for (size_t i = gtid; i < (size_t)R * GH; i += gthreads) { const int row = (int)(i / GH), h = (int)(i % GH);
        GB[(size_t)row * 16 + h] = -__expf(Alog[h]) * fast_softplus(bf2f(((const bf16_t*)USM)[(size_t)row * USMW + SM_A + h]) + dtb[h]);
        GB[(size_t)row * 16 + 8 + h] = fast_sigmoid(bf2f(((const bf16_t*)USM)[(size_t)row * USMW + SM_B + h])); }
}
NOINL void ph_tok_mla(int l) {
    using namespace K; GIDS
    const float* USM = uni(PRM.USM); float* CKV = uni(PRM.CKV); float* KR = uni(PRM.KR); float* out = uni(PRM.out); const float* ROT = uni(PRM.ROT); bf16_t* AQ = uni(PRM.AQ); bf16_t* AKV = uni(PRM.AKV); bf16_t* Kb = uni(PRM.Kb);
    const float* gq = uni(PRM.mla_q_norm_g) + (size_t)l * QL; const float* gkv = uni(PRM.mla_kv_norm_g) + (size_t)l * KVL;
    for (int rowA = gwave; rowA < R; rowA += 2 * gwaves) {
        unsigned a2r[2][6], c2r[2][4], x12r[2][2];
#pragma unroll
        for (int k = 0; k < 2; ++k) { const int row = rowA + k * gwaves < R ? rowA + k * gwaves : rowA; const bf16_t* ur = (const bf16_t*)USM + (size_t)row * USMW;
#pragma unroll
            for (int i = 0; i < 6; ++i) a2r[k][i] = ur[SM_MQ + i * 64 + lane];
#pragma unroll
            for (int i = 0; i < 4; ++i) c2r[k][i] = ur[SM_MKV + i * 64 + lane];
            x12r[k][0] = ur[SM_MKV + KVL + (lane & 15)]; x12r[k][1] = ur[SM_MKV + KVL + 16 + (lane & 15)]; }
        __builtin_amdgcn_sched_barrier(0);
        float a2[2][6], c2[2][4], x12[2][2];
#pragma unroll
        for (int k = 0; k < 2; ++k) {
#pragma unroll
            for (int i = 0; i < 6; ++i) a2[k][i] = __uint_as_float(a2r[k][i] << 16);
#pragma unroll
            for (int i = 0; i < 4; ++i) c2[k][i] = __uint_as_float(c2r[k][i] << 16);
            x12[k][0] = __uint_as_float(x12r[k][0] << 16); x12[k][1] = __uint_as_float(x12r[k][1] << 16); }
#pragma unroll
        for (int k = 0; k < 2; ++k) { const int row = rowA + k * gwaves; if (row < R) {
            float ss = 0.f;
#pragma unroll
            for (int i = 0; i < 6; ++i) ss += a2[k][i] * a2[k][i];
            ss = wave_sum(ss, lane); float rs = rsqrtf(ss * (1.0f / QL) + EPS);
#pragma unroll
            for (int i = 0; i < 6; ++i) AQ[(size_t)row * QL + i * 64 + lane] = f2bf(a2[k][i] * rs * gq[i * 64 + lane]);
            ss = 0.f;
#pragma unroll
            for (int i = 0; i < 4; ++i) ss += c2[k][i] * c2[k][i];
            ss = wave_sum(ss, lane); rs = rsqrtf(ss * (1.0f / KVL) + EPS);
            float* ckvo = row < NP ? out + O_CKVP + ((size_t)l * NP + row) * KVL : out + O_CKVS + ((size_t)l * BS + (row - NP)) * KVL;
#pragma unroll
            for (int i = 0; i < 4; ++i) { const float v = c2[k][i] * rs * gkv[i * 64 + lane]; if (row >= NP) CKV[(size_t)row * KVL + i * 64 + lane] = v; ckvo[i * 64 + lane] = v; AKV[(size_t)row * KVL + i * 64 + lane] = f2bf(v); }
            if (lane < 32) {
                const int i = lane & 15; const float2 cs = *(const float2*)(ROT + (size_t)(pslot_of_row(row) * 16 + i) * 2);
                const float c = cs.x, sn = cs.y;
                const float x1 = x12[k][0], x2 = x12[k][1];
                const float v = lane < 16 ? (x1 * c - x2 * sn) : (x2 * c + x1 * sn);
                if (row >= NP) KR[(size_t)row * ROPE + lane] = v;
                if (row < NP) { const bf16_t vb = f2bf(v); bf16_t* kp = Kb + (size_t)row * 768 + 64 + 2 * i + (lane >> 4);
#pragma unroll
                    for (int hh = 0; hh < MH; ++hh) kp[hh * 96] = vb; }
                float* kro = row < NP ? out + O_KRP + ((size_t)l * NP + row) * ROPE : out + O_KRS + ((size_t)l * BS + (row - NP)) * ROPE;
                kro[lane] = v;
            } } }
    }
}
NOINL void ph_gemm_qkv(int l) {
    using namespace K;
    { const EpiQ E{uni(PRM.Qb), uni(PRM.ROT)}; const bf16_t* W = uni(PRM.WUQP) + (size_t)l * 768 * QL; const bf16_t* A = uni(PRM.AQ);
      pg8::StaticOrder S; S.init(NP, 768, ogrid(), obid());
      pg8::gemm_phase(GEMM_LDS, A, QL, W, QL, S, E); }
    { const EpiF32 E{uni(PRM.Q), 768}; pg8::gemm_skinny<4>(uni(PRM.AQ) + (size_t)NP * QL, QL, uni(PRM.WUQ) + (size_t)l * 768 * QL, 768, QL, NP, 192, E); }
    { const EpiK E{uni(PRM.Kb)}; const bf16_t* W = uni(PRM.WK) + (size_t)l * 512 * KVL; const bf16_t* A = uni(PRM.AKV);
      pg8::StaticOrder S; S.init(NP, 512, ogrid(), obid());
      pg8::gemm_phase(GEMM_LDS, A, KVL, W, KVL, S, E); }
    { const EpiBf16 E{uni(PRM.Vt), NP}; const bf16_t* A = uni(PRM.WV) + (size_t)l * 1024 * KVL; const bf16_t* Bt = uni(PRM.AKV);
      pg8::StaticOrder S; S.init(1024, NP, ogrid(), obid());
      pg8::gemm_phase(GEMM_LDS, A, KVL, Bt, KVL, S, E); }
}
NOINL void ph_rope_q() {
    using namespace K; GIDS
    float* Q = uni(PRM.Q); const float* ROT = uni(PRM.ROT);
    for (size_t i = gtid; i < (size_t)BS * MH * 16; i += gthreads) {
        const int row = NP + (int)(i / (MH * 16)), h = (int)((i / 16) % MH), ii = (int)(i % 16);
        const float2 cs = *(const float2*)(ROT + (size_t)(pslot_of_row(row) * 16 + ii) * 2);
        const float c = cs.x, sn = cs.y;
        float* qp = Q + (size_t)row * 768 + h * 96 + 64;
        const float x1 = qp[ii], x2 = qp[16 + ii];
        qp[ii] = x1 * c - x2 * sn; qp[16 + ii] = x2 * c + x1 * sn;
    }
}
NOINL void ph_rg_prompt(int l, int u0, int ust) {
    using namespace K;
    const int tid = otid(), lane = tid & 63, wid = tid >> 6, fr = lane & 15, fq = lane >> 4, bid = obid(), grid = ogrid();
    LAS unsigned char* base = (LAS unsigned char*)(dyn_lds + 1024);
    LAS bf16_t* XA = (LAS bf16_t*)base;
    LAS float* XCF = (LAS float*)(base + 17408);
    LAS float* AS = (LAS float*)(base + 34816);
    LAS float* BS_ = (LAS float*)(base + 34816 + 16640);
    LAS float* PA = (LAS float*)(base + 34816 + 2 * 16640);
    LAS float* PH = PA + 512;
    LAS float* CARRY = PH + 512;
    const bf16_t* URX = uni(PRM.URX); const bf16_t* GYp = uni(PRM.GY); bf16_t* CAT = uni(PRM.CAT); float* out = uni(PRM.out);
    const int tb = wid & 3, chh = wid >> 2;
    const int cc = tid & 127, seg = tid >> 7;
    const int chs = tid & 63, tg = tid >> 6;
    for (int unit = u0; unit < BP * RGN * 2; unit += ust) {
        const int b = unit / (RGN * 2), n = (unit % (RGN * 2)) >> 1, half = unit & 1, ch0 = n * RGB + half * 64;
        pg8::bf16x8 wfr[4][4];
        { const bf16_t* W = uni(PRM.WRG) + ((size_t)l * RGN + n) * 256 * 128;
#pragma unroll
          for (int nbk = 0; nbk < 4; ++nbk)
#pragma unroll
            for (int ks = 0; ks < 4; ++ks) wfr[nbk][ks] = *(const pg8::bf16x8*)(W + (size_t)((nbk >> 1) * 128 + half * 64 + chh * 32 + (nbk & 1) * 16 + fr) * 128 + ks * 32 + 8 * fq); }
        float cba[2][4], cbx[2][4], csp[2][4];
#pragma unroll
        for (int nb = 0; nb < 2; ++nb)
#pragma unroll
            for (int r = 0; r < 4; ++r) { const int c = ch0 + chh * 32 + nb * 16 + 4 * fq + r;
                cba[nb][r] = uni(PRM.rg_ba)[(size_t)l * DRNN + c]; cbx[nb][r] = uni(PRM.rg_bx)[(size_t)l * DRNN + c]; csp[nb][r] = uni(PRM.SPL)[(size_t)l * DRNN + c]; }
        float cw[4]; const float cbias = uni(PRM.rg_conv_b)[(size_t)l * DRNN + n * RGB + cc];
#pragma unroll
        for (int j = 0; j < 4; ++j) cw[j] = uni(PRM.rg_conv_w)[((size_t)l * 4 + j) * DRNN + n * RGB + cc];
        __syncthreads();
        if (tid < 128) CARRY[tid] = 0.f;
        const bf16_t* ux = URX + (size_t)(b * SEQ) * DRNN + n * RGB + cc;
        const bf16_t* uy = GYp + (size_t)(b * SEQ) * DRNN + ch0 + chs;
        unsigned raw[19], gy[8];
        {   int r0 = seg * 16 - 3, r1 = tg * 8;
            asm volatile("" : "+v"(r0), "+v"(r1));
#pragma unroll
            for (int i = 0; i < 19; ++i) { const int t = r0 + i; raw[i] = t >= 0 ? (unsigned)ux[(unsigned)(t < 0 ? 0 : t) * (unsigned)DRNN] : 0u; }
#pragma unroll
            for (int i = 0; i < 8; ++i) gy[i] = (unsigned)uy[(unsigned)(r1 + i) * (unsigned)DRNN]; }
        float hlast = 0.f;
        for (int tile = 0; tile < SEQ / 64; ++tile) {
#pragma unroll
            for (int j = 0; j < 16; ++j) {
                const float xc = cbias + cw[0] * __uint_as_float(raw[j] << 16) + cw[1] * __uint_as_float(raw[j + 1] << 16) + cw[2] * __uint_as_float(raw[j + 2] << 16) + cw[3] * __uint_as_float(raw[j + 3] << 16);
                XA[(seg * 16 + j) * 136 + cc] = f2bf(xc);
                if ((cc >> 6) == half) XCF[(seg * 16 + j) * 68 + (cc & 63)] = xc;
            }
            float gyc[8];
#pragma unroll
            for (int i = 0; i < 8; ++i) gyc[i] = __uint_as_float(gy[i] << 16);
            if (tile + 1 < SEQ / 64) {
                int r0 = (tile + 1) * 64 + seg * 16 - 3, r1 = (tile + 1) * 64 + tg * 8;
                asm volatile("" : "+v"(r0), "+v"(r1));
#pragma unroll
                for (int i = 0; i < 19; ++i) raw[i] = (unsigned)ux[(unsigned)(r0 + i) * (unsigned)DRNN];
#pragma unroll
                for (int i = 0; i < 8; ++i) gy[i] = (unsigned)uy[(unsigned)(r1 + i) * (unsigned)DRNN];
            }
            lds_barrier();
            f32x4 acc[4];
#pragma unroll
            for (int nbk = 0; nbk < 4; ++nbk) acc[nbk] = (f32x4){0.f, 0.f, 0.f, 0.f};
#pragma unroll
            for (int ks = 0; ks < 4; ++ks) {
                const pg8::bf16x8 xf = *(const LAS pg8::bf16x8*)(XA + (tb * 16 + fr) * 136 + ks * 32 + 8 * fq);
#pragma unroll
                for (int nbk = 0; nbk < 4; ++nbk) acc[nbk] = __builtin_amdgcn_mfma_f32_16x16x32_bf16(wfr[nbk][ks], xf, acc[nbk], 0, 0, 0);
            }
            { const int tok = tb * 16 + fr;
#pragma unroll
              for (int nb = 0; nb < 2; ++nb)
#pragma unroll
                for (int r = 0; r < 4; ++r) {
                    const int c = chh * 32 + nb * 16 + 4 * fq + r;
                    const float rg = fast_sigmoid(acc[nb][r] + cba[nb][r]), ig = fast_sigmoid(acc[2 + nb][r] + cbx[nb][r]);
                    const float la = rg * csp[nb][r];
                    const float a = __expf(la), bm = sqrtf(neg_expm1_small(2.0f * la));
                    AS[tok * 65 + c] = a; BS_[tok * 65 + c] = bm * (ig * XCF[tok * 68 + c]);
                } }
            lds_barrier();
            float av[8], bv[8]; float P = 1.f, H = 0.f;
#pragma unroll
            for (int i = 0; i < 8; ++i) { av[i] = AS[(tg * 8 + i) * 65 + chs]; bv[i] = BS_[(tg * 8 + i) * 65 + chs]; P *= av[i]; H = av[i] * H + bv[i]; }
            PA[tg * 64 + chs] = P; PH[tg * 64 + chs] = H;
            lds_barrier();
            float h = CARRY[(tile & 1) * 64 + chs];
            for (int g = 0; g < tg; ++g) h = PA[g * 64 + chs] * h + PH[g * 64 + chs];
            bf16_t* op = CAT + (size_t)(b * SEQ + tile * 64 + tg * 8) * CATW + CAT_RG + ch0 + chs;
#pragma unroll
            for (int i = 0; i < 8; ++i) { h = av[i] * h + bv[i]; op[(size_t)i * CATW] = f2bf(h * fast_gelu_tanh(gyc[i])); }
            if (tg == 7) { CARRY[((tile + 1) & 1) * 64 + chs] = h; hlast = h; }
        }
        if (tg == 7) out[O_RGHP + ((size_t)l * BP + b) * DRNN + ch0 + chs] = hlast;
    }
    __syncthreads();
}
namespace dc { constexpr int QLS = 0, PW = 9216, AL = PW + 8 * 1024, CMB = AL + 8 * 64, WSTR = 16 * 592, QB16 = CMB + 8 * WSTR + 512;
    static_assert(8 * 264 * 4 <= WSTR && QB16 + 16 * 592 <= 131072, "decode LDS map"); }
NOINL void ph_attn_sample(int l, int u0, int ust) {
    using namespace K;
    const int tid = otid(), lane = tid & 63, w = __builtin_amdgcn_readfirstlane(tid >> 6), fr = lane & 15, fq = lane >> 4;
    LAS float* ldsf = (LAS float*)(dyn_lds + 1024);
    LAS float* QLs = ldsf + dc::QLS / 4;
    LAS float* Pw = ldsf + dc::PW / 4 + w * 256;
    LAS float* ALw = ldsf + dc::AL / 4 + w * 16;
    LAS float* CMB = ldsf + dc::CMB / 4;
    const bf16_t* WKl = uni(PRM.WK) + (size_t)l * 512 * KVL; const float* ckvl = uni(PRM.cache_ckv) + (size_t)l * NPOOL * PAGE * KVL; const float* krl = uni(PRM.cache_krope) + (size_t)l * NPOOL * PAGE * ROPE;
    const float* Q = uni(PRM.Q); const int* ptab = uni(PRM.page_table); float* PART = uni(PRM.PART); float* QLG = uni(PRM.QLG); const float* ROT = uni(PRM.ROT);
    const float sc = 0.10206207261596577f * 1.4426950408889634f;
    for (int unit = u0; unit < BS * 8; unit += ust) {
        const int sb = unit >> 3, sp = unit & 7, row = NP + sb;
        __syncthreads();
        {
            const int t1 = otid(), lane = t1 & 63, w = __builtin_amdgcn_readfirstlane(t1 >> 6);
            const float* qp = Q + (size_t)row * 768 + w * 96;
            const bf16_t* wk = WKl + (size_t)(w * 64) * KVL + 4 * lane;
            float ql[4] = {0.f, 0.f, 0.f, 0.f};
#pragma unroll
            for (int hb = 0; hb < 2; ++hb) {
                u32x2 wr[32];
#pragma unroll
                for (int d = 0; d < 32; ++d) wr[d] = *(const u32x2*)(wk + (size_t)(32 * hb + d) * KVL);
                __builtin_amdgcn_sched_barrier(0);
#pragma unroll
                for (int d = 0; d < 32; ++d) { const float qv = qp[32 * hb + d];
                    ql[0] = fmaf(qv, __uint_as_float(wr[d].x << 16), ql[0]); ql[1] = fmaf(qv, __uint_as_float(wr[d].x & 0xffff0000u), ql[1]);
                    ql[2] = fmaf(qv, __uint_as_float(wr[d].y << 16), ql[2]); ql[3] = fmaf(qv, __uint_as_float(wr[d].y & 0xffff0000u), ql[3]); }
                __builtin_amdgcn_sched_barrier(0);
            }
#pragma unroll
            for (int j = 0; j < 4; ++j) QLs[w * 288 + 4 * lane + j] = ql[j] * sc;
            if (lane < 32) { const int i = lane & 15; const float2 cs = *(const float2*)(ROT + (size_t)(SEQ * 16 + i) * 2);
                const float x1 = qp[64 + i], x2 = qp[80 + i]; QLs[w * 288 + 256 + lane] = (lane < 16 ? x1 * cs.x - x2 * cs.y : x2 * cs.x + x1 * cs.y) * sc; }
        }
        __syncthreads();
        if (sp == 0) for (int i = otid(); i < 8 * 288; i += 512) QLG[(size_t)sb * 8 * 288 + i] = QLs[i];
        for (int i = otid(); i < 16 * 36; i += 512) { const int rr = i / 36, c = i - 36 * rr; u32x4 t = {0u, 0u, 0u, 0u};
            if (rr < 8) { const LAS float* p = QLs + rr * 288 + 8 * c; t.x = cvt_pk_bf16(p[0], p[1]); t.y = cvt_pk_bf16(p[2], p[3]); t.z = cvt_pk_bf16(p[4], p[5]); t.w = cvt_pk_bf16(p[6], p[7]); }
            *(LAS u32x4*)(dyn_lds + 1024 + dc::QB16 + rr * 592 + c * 16) = t; }
        __syncthreads();
        const LAS unsigned char* qfl = (const LAS unsigned char*)(dyn_lds + 1024 + dc::QB16) + fr * 592 + fq * 16;
        float mrun[4], lrun[4], acc[8][4];
#pragma unroll
        for (int r = 0; r < 4; ++r) { mrun[r] = -1e30f; lrun[r] = 0.f; }
#pragma unroll
        for (int hh = 0; hh < 8; ++hh)
#pragma unroll
            for (int j = 0; j < 4; ++j) acc[hh][j] = 0.f;
        const __amdgpu_buffer_rsrc_t rC = __builtin_amdgcn_make_buffer_rsrc((void*)ckvl, 0, 0x7ffffff0, 0x00020000), rK = __builtin_amdgcn_make_buffer_rsrc((void*)krl, 0, 0x7ffffff0, 0x00020000);
        const int voP = lane * 16;
        LAS unsigned char* tw = (LAS unsigned char*)(dyn_lds + 1024 + dc::CMB) + w * dc::WSTR;
        const LAS unsigned char* tfr = tw + fr * 592 + fq * 16;
        LAS unsigned char* twv = tw + lane * 8;
        LAS unsigned char* twk = tw + (lane >> 3) * 592 + 512 + (lane & 7) * 8;
        const int pg0 = __builtin_amdgcn_readfirstlane(ptab[sb * NPAGES + sp * 16 + 2 * w]), pg1 = __builtin_amdgcn_readfirstlane(ptab[sb * NPAGES + sp * 16 + 2 * w + 1]);
        u32x4 V[16], KRr[2];
        {   const int rowb = pg0 * PAGE;
#pragma unroll
            for (int j = 0; j < 2; ++j) KRr[j] = __builtin_amdgcn_raw_buffer_load_b128(rK, voP, (rowb + 8 * j) * ROPE * 4, 0);
#pragma unroll
            for (int q = 0; q < 16; ++q) V[q] = __builtin_amdgcn_raw_buffer_load_b128(rC, voP, (rowb + q) * KVL * 4, 0);
            __builtin_amdgcn_sched_barrier(0); }
#pragma unroll 1
        for (int it = 0; it < 16; ++it) {
#pragma unroll
            for (int j = 0; j < 2; ++j) { u32x2 t; t.x = cvt_pk_bf16(__uint_as_float(KRr[j].x), __uint_as_float(KRr[j].y)); t.y = cvt_pk_bf16(__uint_as_float(KRr[j].z), __uint_as_float(KRr[j].w)); *(LAS u32x2*)(twk + j * 8 * 592) = t; }
#pragma unroll
            for (int q = 0; q < 16; ++q) { u32x2 t; t.x = cvt_pk_bf16(__uint_as_float(V[q].x), __uint_as_float(V[q].y)); t.y = cvt_pk_bf16(__uint_as_float(V[q].z), __uint_as_float(V[q].w)); *(LAS u32x2*)(twv + q * 592) = t; }
            __builtin_amdgcn_sched_barrier(0);
            const int itn = it < 15 ? it + 1 : 15;
            const int rown = ((itn >> 3) ? pg1 : pg0) * PAGE + (itn & 7) * 16;
#pragma unroll
            for (int j = 0; j < 2; ++j) KRr[j] = __builtin_amdgcn_raw_buffer_load_b128(rK, voP, (rown + 8 * j) * ROPE * 4, 0);
            f32x4 s = {0.f, 0.f, 0.f, 0.f};
#pragma unroll
            for (int ks = 0; ks < 9; ++ks) s = __builtin_amdgcn_mfma_f32_16x16x32_bf16(*(const LAS pg8::bf16x8*)(qfl + 64 * ks), *(const LAS pg8::bf16x8*)(tfr + 64 * ks), s, 0, 0, 0);
            __builtin_amdgcn_sched_barrier(0);
            float alpha[4];
#pragma unroll
            for (int r = 0; r < 4; ++r) {
                const float mx = row16_max(s[r]);
                const float mn = fmaxf(mrun[r], mx); alpha[r] = __builtin_amdgcn_exp2f(mrun[r] - mn); mrun[r] = mn;
                s[r] = __builtin_amdgcn_exp2f(s[r] - mn);
                const float ps = row16_sum(s[r]);
                lrun[r] = lrun[r] * alpha[r] + ps;
            }
            if (fq < 2) {
                *(LAS f32x4*)(Pw + fr * 8 + 4 * fq) = s;
                if (fr == 0) *(LAS f32x4*)(ALw + 4 * fq) = (f32x4){alpha[0], alpha[1], alpha[2], alpha[3]};
            }
            asm volatile("" ::: "memory");
            { const f32x4 a0 = *(const LAS f32x4*)ALw, a1 = *(const LAS f32x4*)(ALw + 4);
#pragma unroll
              for (int j = 0; j < 4; ++j) { acc[0][j] *= a0[0]; acc[1][j] *= a0[1]; acc[2][j] *= a0[2]; acc[3][j] *= a0[3]; acc[4][j] *= a1[0]; acc[5][j] *= a1[1]; acc[6][j] *= a1[2]; acc[7][j] *= a1[3]; } }
            __builtin_amdgcn_sched_barrier(0);
#pragma unroll
            for (int g = 0; g < 4; ++g) {
#pragma unroll
                for (int q = 4 * g; q < 4 * g + 4; ++q) { const float cx = __uint_as_float(V[q].x), cy = __uint_as_float(V[q].y), cz = __uint_as_float(V[q].z), cw_ = __uint_as_float(V[q].w);
                    const f32x4 p0 = *(const LAS f32x4*)(Pw + q * 8), p1 = *(const LAS f32x4*)(Pw + q * 8 + 4);
#pragma unroll
                    for (int hh = 0; hh < 8; ++hh) { const float ph = hh < 4 ? p0[hh] : p1[hh - 4];
                        acc[hh][0] = fmaf(ph, cx, acc[hh][0]); acc[hh][1] = fmaf(ph, cy, acc[hh][1]); acc[hh][2] = fmaf(ph, cz, acc[hh][2]); acc[hh][3] = fmaf(ph, cw_, acc[hh][3]); } }
                __builtin_amdgcn_sched_barrier(0);
#pragma unroll
                for (int q = 4 * g; q < 4 * g + 4; ++q) V[q] = __builtin_amdgcn_raw_buffer_load_b128(rC, voP, (rown + q) * KVL * 4, 0);
                __builtin_amdgcn_sched_barrier(0);
            }
            asm volatile("" ::: "memory");
        }
        const int t3 = otid(), lane3 = t3 & 63, w3 = t3 >> 6;
#pragma unroll
        for (int hh = 0; hh < 8; ++hh) *(LAS f32x4*)(CMB + w3 * (dc::WSTR / 4) + hh * 264 + 4 * lane3) = (f32x4){acc[hh][0], acc[hh][1], acc[hh][2], acc[hh][3]};
        if ((lane3 >> 4) < 2 && (lane3 & 15) == 0) {
#pragma unroll
            for (int r = 0; r < 4; ++r) { CMB[w3 * (dc::WSTR / 4) + (4 * (lane3 >> 4) + r) * 264 + 256] = mrun[r]; CMB[w3 * (dc::WSTR / 4) + (4 * (lane3 >> 4) + r) * 264 + 257] = lrun[r]; }
        }
        __syncthreads();
        {   const int lane = lane3, w = w3;
            float M = -1e30f;
#pragma unroll
            for (int ww = 0; ww < 8; ++ww) M = fmaxf(M, CMB[ww * (dc::WSTR / 4) + w * 264 + 256]);
            float L = 0.f; f32x4 o = {0.f, 0.f, 0.f, 0.f};
#pragma unroll
            for (int ww = 0; ww < 8; ++ww) { const LAS float* c = CMB + ww * (dc::WSTR / 4) + w * 264; const float f = __builtin_amdgcn_exp2f(c[256] - M); L += c[257] * f; o += *(const LAS f32x4*)(c + 4 * lane) * f; }
            float* pp = PART + ((size_t)(sb * 8 + sp) * 8 + w) * 264;
            *(f32x4*)(pp + 4 * lane) = o; if (lane == 0) { pp[256] = M; pp[257] = L; }
        }
    }
    __syncthreads();
}
NOINL void ph_gdn_out(int l);
NOINL void ph_decode_combine(int l) {
    using namespace K;
    const int tid = otid(), lane = tid & 63, w = __builtin_amdgcn_readfirstlane(tid >> 6);
    LAS float* red = (LAS float*)(dyn_lds + 1024);
    const float* wukv = uni(PRM.w_ukv) + (size_t)l * KVL * 1536; const float* PART = uni(PRM.PART); const float* QLG = uni(PRM.QLG);
    const float* CKV = uni(PRM.CKV); const float* KR = uni(PRM.KR); bf16_t* CAT = uni(PRM.CAT);
    for (int wu = obid(); wu < BS * MH; wu += ogrid()) {
        const int sb = wu >> 3, h = wu & 7, row = NP + sb;
        const float* ql = QLG + ((size_t)sb * 8 + h) * 288;
        const float4 cv = *(const float4*)(CKV + (size_t)row * KVL + 4 * lane); const float4 q4 = *(const float4*)(ql + 4 * lane);
        const float qrl = lane < 32 ? ql[256 + lane] : 0.f, krl = lane < 32 ? KR[(size_t)row * ROPE + lane] : 0.f;
        float pm[8], pl[8]; float4 pa[8];
#pragma unroll
        for (int sp = 0; sp < 8; ++sp) { const float* pp = PART + ((size_t)(sb * 8 + sp) * 8 + h) * 264; pm[sp] = pp[256]; pl[sp] = pp[257]; pa[sp] = *(const float4*)(pp + 4 * lane); }
        float wv0[32], wv1[32];
#pragma unroll
        for (int cc = 0; cc < 8; ++cc)
#pragma unroll
            for (int j = 0; j < 4; ++j) { const float* wr = wukv + (size_t)(4 * (8 * w + cc) + j) * 1536 + h * 192 + 64; wv0[4 * cc + j] = wr[lane]; wv1[4 * cc + j] = wr[lane + 64]; }
        __builtin_amdgcn_sched_barrier(0);
        if (wu == obid()) ph_gdn_out(l);
        __builtin_amdgcn_sched_barrier(0);
        float t = q4.x * cv.x + q4.y * cv.y + q4.z * cv.z + q4.w * cv.w + qrl * krl;
        const float sself = wave_sum(t, lane);
        float M = sself;
#pragma unroll
        for (int sp = 0; sp < 8; ++sp) M = fmaxf(M, pm[sp]);
        const float fs = __builtin_amdgcn_exp2f(sself - M);
        float L = fs; float o[4] = {fs * cv.x, fs * cv.y, fs * cv.z, fs * cv.w};
#pragma unroll
        for (int sp = 0; sp < 8; ++sp) { const float f = __builtin_amdgcn_exp2f(pm[sp] - M); L += pl[sp] * f;
            o[0] = fmaf(pa[sp].x, f, o[0]); o[1] = fmaf(pa[sp].y, f, o[1]); o[2] = fmaf(pa[sp].z, f, o[2]); o[3] = fmaf(pa[sp].w, f, o[3]); }
        const float il = 1.0f / L;
#pragma unroll
        for (int j = 0; j < 4; ++j) o[j] *= il;
        float o0 = 0.f, o1 = 0.f;
#pragma unroll
        for (int cc = 0; cc < 8; ++cc)
#pragma unroll
            for (int j = 0; j < 4; ++j) { const float ol = __int_as_float(__builtin_amdgcn_readlane(__float_as_int(o[j]), 8 * w + cc)); o0 = fmaf(ol, wv0[4 * cc + j], o0); o1 = fmaf(ol, wv1[4 * cc + j], o1); }
        __syncthreads();
        red[w * 128 + lane] = o0; red[w * 128 + 64 + lane] = o1;
        __syncthreads();
        if (w == 0) { float s0 = 0.f, s1 = 0.f;
#pragma unroll
            for (int ww = 0; ww < 8; ++ww) { s0 += red[ww * 128 + lane]; s1 += red[ww * 128 + 64 + lane]; }
            bf16_t* op = CAT + (size_t)row * CATW + CAT_MLA + h * 128;
            op[lane] = f2bf(s0); op[lane + 64] = f2bf(s1); }
    }
}
NOINL void ph_seq(int l) {
    using namespace K;
    constexpr int BIG = 1 << 30;
    { const int bid = obid(), grid = ogrid();
      ph_gdn_seq(l, bid, grid);
      ph_gdn_sample(l, (bid + grid - 64) % grid, grid);
      if (bid >= 64 && bid < 96) ph_rg_sample(l, bid - 64, 32);
      ph_rg_prompt(l, bid >= 160 ? bid - 160 : (1 << 30), 96); }
    constexpr unsigned DEC_CAP = 128;
    LAS int* slot = (LAS int*)(dyn_lds + 32);
    unsigned* cdec = uni(PRM.bar) + 3520 + 128 * l; unsigned* cact = cdec + 32; unsigned* catt = cdec + 64;
#pragma unroll 1
    for (int round = 0; round < 2; ++round) {
        for (;;) {
            __syncthreads();
            if (otid() == 0) {
                int q = BIG;
                const unsigned act = __hip_atomic_fetch_add(cact, 1u, __ATOMIC_RELAXED, __HIP_MEMORY_SCOPE_AGENT);
                if (act < DEC_CAP || round > 0) q = (int)__hip_atomic_fetch_add(cdec, 1u, __ATOMIC_RELAXED, __HIP_MEMORY_SCOPE_AGENT);
                if (q >= BS * 8) __hip_atomic_fetch_sub(cact, 1u, __ATOMIC_RELAXED, __HIP_MEMORY_SCOPE_AGENT);
                *slot = q;
            }
            __syncthreads();
            const int q = __builtin_amdgcn_readfirstlane(*slot);
            if (q >= BS * 8) break;
            ph_attn_sample(l, q, BIG);
            if (otid() == 0) __hip_atomic_fetch_sub(cact, 1u, __ATOMIC_RELAXED, __HIP_MEMORY_SCOPE_AGENT);
        }
        {   const bf16_t* Qb = uni(PRM.Qb); const bf16_t* Kb = uni(PRM.Kb); const bf16_t* Vt = uni(PRM.Vt); bf16_t* CAT = uni(PRM.CAT);
            for (;;) {
                __syncthreads();
                if (otid() == 0) *slot = (int)__hip_atomic_fetch_add(catt, 1u, __ATOMIC_RELAXED, __HIP_MEMORY_SCOPE_AGENT);
                __syncthreads();
                const int u = __builtin_amdgcn_readfirstlane(*slot);
                if (u >= BP * MH * 8) break;
                const int bh = u & 63;
                attn_prompt_block(Qb, Kb, Vt, CAT, bh >> 3, bh & 7, 7 - (u >> 6), otid());
            } }
    }
    __syncthreads();
}
NOINL void ph_gdn_out(int l) {
    using namespace K; GIDS
    const float* ng = uni(PRM.gdn_norm_g) + (size_t)l * GDV; const float* OG = uni(PRM.OG); const bf16_t* SZ = uni(PRM.SZ); bf16_t* CAT = uni(PRM.CAT);
    const size_t nit = (size_t)R * 128;
    const int c0 = (int)(gtid & 127) * 8;
    const float4 g0 = *(const float4*)(ng + (c0 & 127)), g1 = *(const float4*)(ng + (c0 & 127) + 4);
    const float gg[8] = {g0.x, g0.y, g0.z, g0.w, g1.x, g1.y, g1.z, g1.w};
    u32x4 on_[2]; u32x4 zn[2];
    auto ldi = [&](size_t it0) {
#pragma unroll
        for (int k = 0; k < 2; ++k) { const size_t it = it0 + k * gthreads; const size_t itc = it < nit ? it : gtid; const int row = (int)(itc >> 7);
            on_[k] = *(const u32x4*)((const bf16_t*)OG + (size_t)row * GVW + c0); zn[k] = *(const u32x4*)(SZ + (size_t)row * D + c0); } };
    if (gtid < nit) ldi(gtid);
    for (size_t it0 = gtid; it0 < nit; it0 += 2 * gthreads) {
        u32x4 ow[2]; u32x4 zw[2];
#pragma unroll
        for (int k = 0; k < 2; ++k) { ow[k] = on_[k]; zw[k] = zn[k]; }
        if (it0 + 2 * gthreads < nit) ldi(it0 + 2 * gthreads);
        __builtin_amdgcn_sched_barrier(0);
#pragma unroll
        for (int k = 0; k < 2; ++k) { const size_t it = it0 + k * gthreads; const bool on = it < nit; const int row = (int)((on ? it : it0) >> 7);
            const float o[8] = {__uint_as_float(ow[k].x << 16), __uint_as_float(ow[k].x & 0xffff0000u), __uint_as_float(ow[k].y << 16), __uint_as_float(ow[k].y & 0xffff0000u),
                                __uint_as_float(ow[k].z << 16), __uint_as_float(ow[k].z & 0xffff0000u), __uint_as_float(ow[k].w << 16), __uint_as_float(ow[k].w & 0xffff0000u)}; float ss = 0.f;
#pragma unroll
            for (int e = 0; e < 8; ++e) ss += o[e] * o[e];
            ss = row16_sum(ss);
            const float rs = rsqrtf(ss * (1.0f / GDV) + EPS);
            const float z[8] = {__uint_as_float(zw[k].x << 16), __uint_as_float(zw[k].x & 0xffff0000u), __uint_as_float(zw[k].y << 16), __uint_as_float(zw[k].y & 0xffff0000u),
                                __uint_as_float(zw[k].z << 16), __uint_as_float(zw[k].z & 0xffff0000u), __uint_as_float(zw[k].w << 16), __uint_as_float(zw[k].w & 0xffff0000u)};
            float zs[8];
#pragma unroll
            for (int e = 0; e < 8; ++e) zs[e] = z[e] * fast_sigmoid(z[e]);
            u32x4 w; w.x = cvt_pk_bf16(o[0] * rs * gg[0] * zs[0], o[1] * rs * gg[1] * zs[1]); w.y = cvt_pk_bf16(o[2] * rs * gg[2] * zs[2], o[3] * rs * gg[3] * zs[3]);
            w.z = cvt_pk_bf16(o[4] * rs * gg[4] * zs[4], o[5] * rs * gg[5] * zs[5]); w.w = cvt_pk_bf16(o[6] * rs * gg[6] * zs[6], o[7] * rs * gg[7] * zs[7]);
            if (on) *(u32x4*)(CAT + (size_t)row * CATW + CAT_GDN + c0) = w; }
    }
}
NOINL void ph_gemm_proj(int l) {
    using namespace K;
    const EpiProj E{CAT_GDN / 64, CAT_MLA / 64, uni(PRM.R1), uni(PRM.R2), uni(PRM.R3), uni(PRM.Mb)}; const bf16_t* W = uni(PRM.WPR) + (size_t)l * WPR_SZ; const bf16_t* A = uni(PRM.CAT);
    pg8::StaticOrder S; S.init(NP, D, ogrid(), obid());
    pg8::gemm_phase(GEMM_LDS, A, CATW, W, CATW, S, E);
    pg8::gemm_skinny<8>(A + (size_t)NP * CATW, CATW, W, D, CATW, NP, 0, E);
}
NOINL void ph_gemm_res(int l, int which) {
    using namespace K;
    const float* cur = l == 0 ? uni(PRM.x_prompt) : uni(PRM.X2); const float* curs = l == 0 ? uni(PRM.x_sample) - (size_t)NP * D : cur; float* mid = uni(PRM.X1); float* nxt = l == 0 ? uni(PRM.X2) : uni(PRM.X0);
    const float* modl = uni(PRM.mod) + (size_t)l * NC * 6 * D;
    const bf16_t* A = which == 0 ? uni(PRM.Mb) : uni(PRM.ACT); const int Kd = which == 0 ? D : DFF;
    const bf16_t* W = which == 0 ? uni(PRM.WO) + (size_t)l * WO_SZ : uni(PRM.WFO) + (size_t)l * WFO_SZ;
    const EpiRes E{which == 0 ? cur : mid, which == 0 ? curs : mid, which == 0 ? mid : nxt, modl + (which == 0 ? 2 * D : 5 * D), (which == 1 || l > 0) ? 1 : 0, (which == 0 || l == 0) ? 1 : 0};
    pg8::StaticOrder S; S.init(NP, D, ogrid(), obid());
    pg8::gemm_phase(GEMM_LDS, A, Kd, W, Kd, S, E);
    pg8::gemm_skinny<8>(A + (size_t)NP * Kd, Kd, W, D, Kd, NP, 0, E);
}
NOINL void ph_gemm_ffn_in(int l) {
    using namespace K;
    const EpiFfnIn E{uni(PRM.ACT)}; const bf16_t* W = uni(PRM.WFI) + (size_t)l * WFI_SZ; const bf16_t* A = uni(PRM.HA);
    pg8::StaticOrder S; S.init(NP, 2 * DFF, ogrid(), obid());
    pg8::gemm_phase(GEMM_LDS, A, D, W, D, S, E);
    pg8::gemm_skinny<8>(A + (size_t)NP * D, D, W, 2 * DFF, D, NP, 128, E, 128);
}
NOINL void ph_final() {
    using namespace K; GIDS
    const float* xf = uni(PRM.X0); const float* gf = uni(PRM.g_final); float* out = uni(PRM.out);
    float4 gf4[4];
#pragma unroll
    for (int i = 0; i < 4; ++i) gf4[i] = *(const float4*)(gf + i * 256 + lane * 4);
    for (int rowA = gwave; rowA < R; rowA += 2 * gwaves) {
        float4 xv[2][4];
#pragma unroll
        for (int k = 0; k < 2; ++k) { const int row = rowA + k * gwaves < R ? rowA + k * gwaves : rowA; const float* xr = xf + (size_t)row * D;
#pragma unroll
            for (int i = 0; i < 4; ++i) xv[k][i] = *(const float4*)(xr + i * 256 + lane * 4); }
        __builtin_amdgcn_sched_barrier(0);
#pragma unroll
        for (int k = 0; k < 2; ++k) { const int row = rowA + k * gwaves; if (row < R) {
            float ss = 0.f;
#pragma unroll
            for (int i = 0; i < 4; ++i) { const float4 t = xv[k][i]; ss += t.x * t.x + t.y * t.y + t.z * t.z + t.w * t.w; }
            ss = wave_sum(ss, lane); const float rs = rsqrtf(ss * (1.0f / D) + EPS);
            float* yo = out + O_YP + (size_t)row * D;
#pragma unroll
            for (int i = 0; i < 4; ++i) { const int c = i * 256 + lane * 4; const float4 t = xv[k][i], g = gf4[i];
                *(float4*)(yo + c) = make_float4(t.x * rs * g.x, t.y * rs * g.y, t.z * rs * g.z, t.w * rs * g.w); } } }
    }
}

#define PRM_FIELDS(X) X(x_prompt) X(x_sample) X(cache_ckv) X(cache_krope) X(state_rg_conv) X(state_rg_h) X(state_gdn_conv) X(state_gdn_S) X(page_table) X(c_prompt) X(c_sample) \
    X(w_ada) X(b_ada) X(g_norm1) X(g_norm2) X(w_in) X(rg_conv_w) X(rg_conv_b) X(rg_wa) X(rg_ba) X(rg_wx) X(rg_bx) X(rg_lambda) X(gdn_conv_w) X(gdn_A_log) X(gdn_dt_bias) X(gdn_norm_g) \
    X(mla_q_norm_g) X(w_uq) X(mla_kv_norm_g) X(w_ukv) X(w_rg_proj) X(w_gdn_proj) X(w_mla_proj) X(w_o) X(w_ffn_in) X(w_ffn_out) X(g_final) X(out) X(bar) \
    X(csilu) X(mod) X(X0) X(X1) X(X2) X(H) X(U) X(XC) X(GR) X(GI) X(QKVC) X(GB) X(OG) X(CQ) X(CKV) X(KR) X(Q) X(KV) X(ROT) X(HA) X(CAT) X(Mb) X(ACT) X(R1) X(R2) X(R3) X(WIN) X(WPR) X(WO) X(WFI) X(WFO) X(WUQ) X(WUKV) X(WRG) X(AQ) X(AKV) X(WUQP) X(WK) X(WV) X(Qb) X(Kb) X(Vt) X(PART) X(QLG) X(SPL) X(URX) X(GY) X(UQKV) X(SZ) X(USM) X(QKb) X(G_UT) X(G_WT) X(G_QG) X(G_KDT) X(G_AQK) X(G_EGL)

__global__ void __launch_bounds__(512, 2) fwd_kernel(Params p) {
    using namespace K;
    if ((threadIdx.x & 63) == 0) ((volatile LAS unsigned char*)(dyn_lds + 1024 - 64))[(unsigned)__builtin_amdgcn_s_getreg((5 << 11) | 4) & 63u] = (unsigned char)(threadIdx.x >> 6);
    if (threadIdx.x == 0) {
        ((volatile LAS unsigned*)dyn_lds)[0] = 0u; ((volatile LAS unsigned*)dyn_lds)[1] = 0u;
        LAS Params* L = (LAS Params*)(dyn_lds + 64);
#define X(f) L->f = p.f;
        PRM_FIELDS(X)
#undef X
    }
    __syncthreads();
    XcdBarrier bar = xcd_barrier_post(p.bar, (volatile LAS unsigned*)dyn_lds);

    ph_init(); { ConvCtx cx{0, obid(), ogrid()}; ph_convert(cx, 0, 0); ph_convert(cx, 0, 1); }
    grid_sync(bar);
    ph_mod_all();
    grid_sync(bar);
    for (int l = 0; l < DEPTH; ++l) {
        ph_norm(l, 0);
        grid_sync(bar);
        ph_gemm_u(l);
        if (l == 0 && obid() >= 64) { ConvCtx cx{0, obid() - 64, ogrid() - 64}; ph_convert(cx, 1, 0); }
        grid_sync(bar);
        ph_tok_gdn(l); ph_tok_mla(l); ph_rg_state_copies(l);
        grid_sync(bar);
        ph_gemm_qkv(l); ph_gdn_prep();
        grid_sync(bar);
        ph_seq(l);
        grid_sync(bar);
        ph_decode_combine(l);
        grid_sync(bar);
        ph_gemm_proj(l);
        grid_sync(bar);
        ph_gemm_res(l, 0);
        grid_sync(bar);
        ph_norm(l, 1);
        grid_sync(bar);
        ph_gemm_ffn_in(l);
        if (l == 0 && obid() >= 128) { ConvCtx cx{0, obid() - 128, ogrid() - 128}; ph_convert(cx, 1, 1); }
        grid_sync(bar);
        ph_gemm_res(l, 1);
        grid_sync(bar);
    }
    ph_final();
}

extern "C" void kernel_launch(void* const* d_in, const int* in_sizes, int n_in, void* d_out, int out_size, void* d_ws, size_t ws_size, hipStream_t stream) {
    using namespace K;
    (void)in_sizes; (void)n_in; (void)out_size; (void)ws_size;
    Params p{};
    p.x_prompt = (const float*)d_in[0]; p.x_sample = (const float*)d_in[1]; p.cache_ckv = (const float*)d_in[2]; p.cache_krope = (const float*)d_in[3];
    p.state_rg_conv = (const float*)d_in[4]; p.state_rg_h = (const float*)d_in[5]; p.state_gdn_conv = (const float*)d_in[6]; p.state_gdn_S = (const float*)d_in[7];
    p.page_table = (const int*)d_in[8]; p.c_prompt = (const float*)d_in[9]; p.c_sample = (const float*)d_in[10];
    p.w_ada = (const float*)d_in[11]; p.b_ada = (const float*)d_in[12]; p.g_norm1 = (const float*)d_in[13]; p.g_norm2 = (const float*)d_in[14]; p.w_in = (const float*)d_in[15];
    p.rg_conv_w = (const float*)d_in[16]; p.rg_conv_b = (const float*)d_in[17]; p.rg_wa = (const float*)d_in[18]; p.rg_ba = (const float*)d_in[19];
    p.rg_wx = (const float*)d_in[20]; p.rg_bx = (const float*)d_in[21]; p.rg_lambda = (const float*)d_in[22];
    p.gdn_conv_w = (const float*)d_in[23]; p.gdn_A_log = (const float*)d_in[24]; p.gdn_dt_bias = (const float*)d_in[25]; p.gdn_norm_g = (const float*)d_in[26];
    p.mla_q_norm_g = (const float*)d_in[27]; p.w_uq = (const float*)d_in[28]; p.mla_kv_norm_g = (const float*)d_in[29]; p.w_ukv = (const float*)d_in[30];
    p.w_rg_proj = (const float*)d_in[31]; p.w_gdn_proj = (const float*)d_in[32]; p.w_mla_proj = (const float*)d_in[33]; p.w_o = (const float*)d_in[34];
    p.w_ffn_in = (const float*)d_in[35]; p.w_ffn_out = (const float*)d_in[36]; p.g_final = (const float*)d_in[37];
    p.out = (float*)d_out;
    char* w = (char*)d_ws; size_t off = 0;
    auto take = [&](size_t nfloats) { float* r = (float*)(w + off); off += ((nfloats * 4 + 255) / 256) * 256; return r; };
    p.bar = (unsigned*)take(4096);
    p.csilu = take((size_t)NC * D); p.mod = take((size_t)DEPTH * NC * 6 * D);
    p.X0 = take((size_t)R * D); p.X1 = take((size_t)R * D); p.X2 = take((size_t)R * D); p.H = nullptr;
    p.U = nullptr; p.XC = take((size_t)R * DRNN); p.GR = nullptr; p.GI = nullptr;
    p.QKVC = take((size_t)R * GC); p.GB = take((size_t)R * 16); p.OG = take((size_t)R * GVW);
    p.CQ = take((size_t)R * QL); p.CKV = take((size_t)R * KVL); p.KR = take((size_t)R * ROPE);
    p.Q = take((size_t)R * 768); p.KV = take((size_t)NP * 1536); p.ROT = take((size_t)(SEQ + 1) * 32);
    auto takeh = [&](size_t nhalf) { return (unsigned short*)take((nhalf + 1) / 2); };
    constexpr size_t RP = 16640;
    p.HA = takeh(RP * D); p.CAT = takeh(RP * CATW); p.Mb = takeh(RP * D); p.ACT = takeh(RP * DFF);
    p.R1 = takeh(RP * D); p.R2 = takeh(RP * D); p.R3 = takeh(RP * D);
    p.WIN = takeh((size_t)DEPTH * WIN_SZ); p.WPR = takeh((size_t)DEPTH * WPR_SZ); p.WO = takeh((size_t)DEPTH * WO_SZ); p.WFI = takeh((size_t)DEPTH * WFI_SZ); p.WFO = takeh((size_t)DEPTH * WFO_SZ);
    p.WUQ = takeh((size_t)DEPTH * 768 * QL); p.WUKV = takeh((size_t)DEPTH * 1536 * KVL); p.WRG = takeh((size_t)DEPTH * RGN * 256 * 128); p.AQ = takeh(RP * QL); p.AKV = takeh(RP * KVL);
    p.WUQP = takeh((size_t)DEPTH * 768 * QL); p.WK = takeh((size_t)DEPTH * 512 * KVL); p.WV = takeh((size_t)DEPTH * 1024 * KVL); p.Qb = takeh(RP * 768); p.Kb = takeh((size_t)NP * 768); p.Vt = takeh((size_t)1024 * NP);
    p.PART = take((size_t)BS * 8 * 8 * 264); p.QLG = take((size_t)BS * 8 * 288); p.SPL = take((size_t)DEPTH * DRNN);
    p.URX = takeh(RP * DRNN); p.GY = takeh(RP * DRNN); p.UQKV = takeh(RP * GC); p.SZ = takeh(RP * D); p.USM = take((size_t)R * 688);
    p.QKb = takeh((size_t)NP * GC); p.G_UT = take((size_t)2048 * 8192); p.G_WT = takeh((size_t)2048 * 8192); p.G_QG = takeh((size_t)2048 * 8192); p.G_KDT = takeh((size_t)2048 * 8192); p.G_AQK = takeh((size_t)2048 * 4096); p.G_EGL = take(2048);
    constexpr size_t kDynLds = 1024 + 131072;
    static int grid = 0;
    if (!grid) {
        (void)hipFuncSetAttribute((const void*)fwd_kernel, hipFuncAttributeMaxDynamicSharedMemorySize, (int)kDynLds);
        int dev = 0, cus = 0, per_cu = 0;
        (void)hipGetDevice(&dev);
        (void)hipDeviceGetAttribute(&cus, hipDeviceAttributeMultiprocessorCount, dev);
        (void)hipOccupancyMaxActiveBlocksPerMultiprocessor(&per_cu, fwd_kernel, 512, kDynLds);
        if (per_cu < 1) per_cu = 1;
        grid = cus > 0 ? cus : 256;
    }
    (void)hipMemsetAsync(p.bar, 0, 4096 * sizeof(unsigned), stream);
    hipLaunchKernelGGL(fwd_kernel, dim3(grid), dim3(512), kDynLds, stream, p);
}
```

```cpp
#include <hip/hip_runtime.h>
#include <stdint.h>

#define XB_TMO      128
#define XB_XCNT(j)  (256  + 64 * (j))
#define XB_XSUB(j)  (1280 + 64 * (j))
#define XB_XGEN(j)  (2304 + 64 * (j))
#define XB_TOP      3328
#define XB_TOPGEN   3392
#define XCD_BAR_WORDS 3456
#define XB_SPIN_CAP (1u << 26)
#define LAS __attribute__((address_space(3)))

__device__ __forceinline__ unsigned xb_ld(unsigned* p)              { return __hip_atomic_load(p, __ATOMIC_RELAXED, __HIP_MEMORY_SCOPE_AGENT); }
__device__ __forceinline__ unsigned xb_add(unsigned* p, unsigned v) { return __hip_atomic_fetch_add(p, v, __ATOMIC_RELAXED, __HIP_MEMORY_SCOPE_AGENT); }
__device__ __forceinline__ unsigned xb_xcc_id() { return (unsigned)__builtin_amdgcn_s_getreg((3 << 11) | 20) & 0xFu; }
#define XB_SPIN(cond, bar) do { unsigned _sp = 0; while (cond) { __builtin_amdgcn_s_sleep(1); \
    if ((++_sp & 255u) == 0u) { if (xb_ld(&(bar)[XB_TMO])) break; if (_sp > XB_SPIN_CAP) { atomicAdd(&(bar)[XB_TMO], 1u); break; } } } } while (0)

struct XcdBarrier { unsigned* bar; unsigned x; volatile LAS unsigned* st; };

__device__ __forceinline__ XcdBarrier xcd_barrier_post(unsigned* bar, volatile LAS unsigned* st) {
    XcdBarrier b; b.bar = bar; b.x = xb_xcc_id(); b.st = st;
    if (threadIdx.x == 0) (void)xb_add(&bar[XB_XCNT(b.x)], 1u);
    return b;
}
__device__ __forceinline__ void xcd_barrier_complete(unsigned* bar, unsigned x, unsigned& nloc, unsigned& nx) {
    const unsigned G = gridDim.x * gridDim.y * gridDim.z;
    unsigned sum, cnt, mine, sp = 0u;
    for (;;) {
        sum = 0u; cnt = 0u; mine = 0u;
#pragma unroll
        for (unsigned j = 0; j < 16; ++j) { const unsigned c = xb_ld(&bar[XB_XCNT(j)]); sum += c; cnt += (c > 0u) ? 1u : 0u; mine = (j == x) ? c : mine; }
        if (sum == G) break;
        __builtin_amdgcn_s_sleep(1);
        if ((++sp & 255u) == 0u) { if (xb_ld(&bar[XB_TMO])) break; if (sp > XB_SPIN_CAP) { atomicAdd(&bar[XB_TMO], 1u); break; } }
    }
    nloc = mine > 0u ? mine : 1u; nx = cnt > 0u ? cnt : 1u;
}
__device__ __forceinline__ void xcd_barrier(const XcdBarrier& b) {
    asm volatile("s_waitcnt vmcnt(0)" ::: "memory");
    __syncthreads();
    if (threadIdx.x == 0) {
        unsigned* bar = b.bar;
        __builtin_amdgcn_s_waitcnt(0);
        unsigned nloc = b.st[0], nx = b.st[1];
        if (nloc == 0u) { xcd_barrier_complete(bar, b.x, nloc, nx); b.st[0] = nloc; b.st[1] = nx; }
        const unsigned old = xb_add(&bar[XB_XSUB(b.x)], 1u);
        const unsigned gen = old / nloc;
        if (old + 1u == (gen + 1u) * nloc) {
            __builtin_amdgcn_fence(__ATOMIC_RELEASE, "agent");
            asm volatile("s_waitcnt vmcnt(0)" ::: "memory");
            const unsigned og = xb_add(&bar[XB_TOP], 1u);
            const unsigned tg = og / nx;
            if (og + 1u == (tg + 1u) * nx) xb_add(&bar[XB_TOPGEN], 1u);
            else XB_SPIN(xb_ld(&bar[XB_TOPGEN]) == tg, bar);
            __builtin_amdgcn_fence(__ATOMIC_ACQUIRE, "agent");
            xb_add(&bar[XB_XGEN(b.x)], 1u);
            asm volatile("s_waitcnt vmcnt(0)" ::: "memory");
        } else {
            XB_SPIN(xb_ld(&bar[XB_XGEN(b.x)]) == gen, bar);
            __builtin_amdgcn_fence(__ATOMIC_ACQUIRE, "agent");
            asm volatile("s_waitcnt vmcnt(0)" ::: "memory");
        }
    }
    __syncthreads();
}

__device__ __forceinline__ void grid_sync(const XcdBarrier& b0) {
    XcdBarrier b = b0;
    unsigned long long pb = (unsigned long long)b.bar; unsigned x = b.x;
    asm volatile("" : "+s"(pb), "+s"(x));
    b.bar = (unsigned*)pb; b.x = x;
    xcd_barrier(b);
}

namespace K {
constexpr int D = 1024, BP = 8, SEQ = 2048, NP = BP * SEQ, BS = 32, R = NP + BS, DEPTH = 2, NC = BP + BS;
constexpr int PAST = 16384, PAGE = 128, NPAGES = PAST / PAGE, NPOOL = (BS * NPAGES * 5) / 4;
constexpr int DRNN = 1280, RGB = 128, RGN = 10;
constexpr int GH = 8, GDK = 128, GDV = 128, GKW = 1024, GVW = 1024, GC = 3072;
constexpr int MH = 8, QL = 384, KVL = 256, NOPE = 64, ROPE = 32, VH = 128, QKD = 96;
constexpr int DFF = 2816, NIN = 10416;
constexpr int U_RX = 0, U_RY = 1280, U_QKV = 2560, U_Z = 5632, U_A = 6656, U_B = 6664, U_MQ = 6672, U_MKV = 7056, U_GATE = 7344;
constexpr int CATW = 3328, CAT_RG = 0, CAT_GDN = 1280, CAT_MLA = 2304;
constexpr float EPS = 1e-6f;
constexpr size_t O_YP = 0, O_YS = O_YP + (size_t)NP * D, O_CKVP = O_YS + (size_t)BS * D, O_KRP = O_CKVP + (size_t)DEPTH * NP * KVL,
    O_RGCP = O_KRP + (size_t)DEPTH * NP * ROPE, O_RGHP = O_RGCP + (size_t)DEPTH * BP * 3 * DRNN, O_GCP = O_RGHP + (size_t)DEPTH * BP * DRNN,
    O_GSP = O_GCP + (size_t)DEPTH * BP * 3 * GC, O_CKVS = O_GSP + (size_t)DEPTH * BP * GH * GDK * GDV, O_KRS = O_CKVS + (size_t)DEPTH * BS * KVL,
    O_RGCS = O_KRS + (size_t)DEPTH * BS * ROPE, O_RGHS = O_RGCS + (size_t)DEPTH * BS * 3 * DRNN, O_GCS = O_RGHS + (size_t)DEPTH * BS * DRNN,
    O_GSS = O_GCS + (size_t)DEPTH * BS * 3 * GC, O_END = O_GSS + (size_t)DEPTH * BS * GH * GDK * GDV;
}

struct Params {
    const float* x_prompt; const float* x_sample; const float* cache_ckv; const float* cache_krope;
    const float* state_rg_conv; const float* state_rg_h; const float* state_gdn_conv; const float* state_gdn_S;
    const int* page_table; const float* c_prompt; const float* c_sample;
    const float* w_ada; const float* b_ada; const float* g_norm1; const float* g_norm2; const float* w_in;
    const float* rg_conv_w; const float* rg_conv_b; const float* rg_wa; const float* rg_ba; const float* rg_wx; const float* rg_bx; const float* rg_lambda;
    const float* gdn_conv_w; const float* gdn_A_log; const float* gdn_dt_bias; const float* gdn_norm_g;
    const float* mla_q_norm_g; const float* w_uq; const float* mla_kv_norm_g; const float* w_ukv;
    const float* w_rg_proj; const float* w_gdn_proj; const float* w_mla_proj; const float* w_o; const float* w_ffn_in; const float* w_ffn_out; const float* g_final;
    float* out; unsigned* bar;
    float* csilu; float* mod; float* X0; float* X1; float* X2; float* H; float* U; float* XC; float* GR; float* GI;
    float* QKVC; float* GB; float* OG; float* CQ; float* CKV; float* KR; float* Q; float* KV; float* CATf_unused; float* M_unused; float* ACT_unused; float* ROT;
    unsigned short* HA; unsigned short* CAT; unsigned short* Mb; unsigned short* ACT; unsigned short* R1; unsigned short* R2; unsigned short* R3;
    unsigned short* WIN; unsigned short* WPR; unsigned short* WO; unsigned short* WFI; unsigned short* WFO;
    unsigned short* WUQ; unsigned short* WUKV; unsigned short* WRG; unsigned short* AQ; unsigned short* AKV;
    unsigned short* WUQP; unsigned short* WK; unsigned short* WV; unsigned short* Qb; unsigned short* Kb; unsigned short* Vt;
    float* PART; float* QLG; float* SPL;
    unsigned short* URX; unsigned short* GY; unsigned short* UQKV; unsigned short* SZ; float* USM;
    unsigned short* QKb; float* G_UT; unsigned short* G_WT; unsigned short* G_QG; unsigned short* G_KDT; unsigned short* G_AQK; float* G_EGL;
};

#define DEVI __device__ __forceinline__
static_assert(sizeof(Params) <= 896, "Params copy must end before the wave table at LDS byte 960");
#define NOINL static __device__ __forceinline__
extern __shared__ __attribute__((aligned(16))) unsigned char dyn_lds[];
#define PRM (*(const LAS Params*)(dyn_lds + 64))
template <class T> DEVI T* uni(T* p) { const unsigned long long v = (unsigned long long)p;
    const unsigned lo = __builtin_amdgcn_readfirstlane((unsigned)v), hi = __builtin_amdgcn_readfirstlane((unsigned)(v >> 32));
    typedef __attribute__((address_space(1))) T GT; return (T*)(GT*)(((unsigned long long)hi << 32) | lo); }
DEVI void lds_barrier() { asm volatile("s_waitcnt lgkmcnt(0)" ::: "memory"); __builtin_amdgcn_s_barrier(); asm volatile("" ::: "memory"); }
#define LDS_DATA ((float*)(dyn_lds + 1024))
#define GEMM_LDS ((LAS unsigned char*)(dyn_lds + 1024))
DEVI int otid() {
    const unsigned key = (unsigned)__builtin_amdgcn_s_getreg((5 << 11) | 4) & 63u;
    int w = ((volatile LAS unsigned char*)(dyn_lds + 1024 - 64))[key];
    int ln; asm volatile("v_mbcnt_lo_u32_b32 %0, -1, 0\n\tv_mbcnt_hi_u32_b32 %0, -1, %0" : "=v"(ln));
    int t = (w << 6) | ln;
    asm volatile("" : "+v"(t)); return t; }
DEVI int obid() { int b = blockIdx.x; asm volatile("" : "+s"(b)); return b; }
DEVI int ogrid() { int g = gridDim.x; asm volatile("" : "+s"(g)); return g; }
DEVI float sigmoid_f(float x) { return 1.0f / (1.0f + expf(-x)); }
DEVI float silu_f(float x) { return x * sigmoid_f(x); }
DEVI float softplus_f(float x) { return fmaxf(x, 0.f) + log1pf(expf(-fabsf(x))); }
DEVI float gelu_tanh_f(float x) { return 0.5f * x * (1.0f + tanhf(0.7978845608028654f * (x + 0.044715f * x * x * x))); }
DEVI float shx(float v, int mask, int lane) { return __int_as_float(__builtin_amdgcn_ds_bpermute((lane ^ mask) << 2, __float_as_int(v))); }
template <int CTRL> DEVI float dpp_mov(float v) { return __int_as_float(__builtin_amdgcn_update_dpp(0, __float_as_int(v), CTRL, 0xF, 0xF, true)); }
DEVI float row16_max(float v) { v = fmaxf(v, dpp_mov<0xB1>(v)); v = fmaxf(v, dpp_mov<0x4E>(v)); v = fmaxf(v, dpp_mov<0x141>(v)); v = fmaxf(v, dpp_mov<0x140>(v)); return v; }
DEVI float row16_sum(float v) { v += dpp_mov<0xB1>(v); v += dpp_mov<0x4E>(v); v += dpp_mov<0x141>(v); v += dpp_mov<0x140>(v); return v; }
DEVI float wave_sum(float v, int lane) {
#pragma unroll
    for (int o = 32; o >= 1; o >>= 1) v += shx(v, o, lane);
    return v;
}
DEVI int cond_of_row(int row) { return row < K::NP ? (row >> 11) : (K::BP + row - K::NP); }
DEVI int pslot_of_row(int row) { return row < K::NP ? (row & (K::SEQ - 1)) : K::SEQ; }
DEVI float rope_inv(int i) { return (float)exp2(-(double)i * (13.287712379549449 / 16.0)); }

namespace pg8 {
typedef unsigned short bf16_t;
typedef short bf16x8 __attribute__((ext_vector_type(8)));
typedef float f32x4 __attribute__((ext_vector_type(4)));
typedef unsigned u32x4 __attribute__((ext_vector_type(4)));
typedef unsigned u32x2 __attribute__((ext_vector_type(2)));
constexpr int BM = 256, BK = 64, HALF = 128, HTB = HALF * BK * 2, STAGE_BYTES = 8 * HTB, NXCD = 8, WGM = 8;
DEVI int lds_byte(int r, int c) { const int st = (r >> 4) * 2 + (c >> 5), rr = r & 15, cc = c & 31, ob = rr * 64 + cc * 2; return st * 1024 + (ob ^ (((ob >> 9) & 1) << 5)); }
DEVI void stage_rc(int b, int& R, int& C) { const int st = b / 1024, sb = b % 1024, swz = sb ^ (((sb >> 9) & 1) << 5); R = (st >> 1) * 16 + swz / 64; C = (st & 1) * 32 + (swz % 64) / 2; }
DEVI int perm32(int rho) { const int n = rho >> 4, i = rho & 15; return 8 * (i >> 2) + 4 * n + (i & 3); }
struct Unit { int pm, pn; };
struct StaticOrder {
    int nM, nN, nwg, G, c;
    DEVI void init(int M, int N, int G_, int c_) { nM = M / BM; nN = N / BM; nwg = nM * nN; G = G_; c = c_; }
    DEVI bool next(int i, Unit& u) const {
        const long L = (long)i * G + c; if (L >= nwg) return false;
        int wgid = (int)L; { const int q = nwg / NXCD, r = nwg % NXCD, xcd = wgid % NXCD, off = wgid / NXCD; wgid = (xcd < r ? xcd * (q + 1) : r * (q + 1) + (xcd - r) * q) + off; }
        const int nig = WGM * nN, gid = wgid / nig, fm = gid * WGM, gsz = (nM - fm) < WGM ? (nM - fm) : WGM;
        u.pm = fm + ((wgid % nig) % gsz); u.pn = (wgid % nig) / gsz; return true;
    }
};
DEVI unsigned cvt_pk_bf16(float lo, float hi) { typedef float f2_t __attribute__((ext_vector_type(2))); typedef __bf16 b2_t __attribute__((ext_vector_type(2)));
    const f2_t v = {lo, hi}; const b2_t r = __builtin_convertvector(v, b2_t); return __builtin_bit_cast(unsigned, r); }

template <class Epi>
DEVI void gemm_phase(LAS unsigned char* lds, const bf16_t* Ap, int lda, const bf16_t* Btp, int K, const StaticOrder& S, const Epi& E) {
    const int tid = otid(), wid = __builtin_amdgcn_readfirstlane(tid >> 6), lane = tid & 63, wr = wid >> 2, wc = wid & 3, fr = lane & 15, fq = lane >> 4;
    const int nt = K / BK;
    unsigned voffA[2], voffB[2];
#pragma unroll
    for (int i = 0; i < 2; ++i) { int R, C; stage_rc(tid * 16 + i * 8192, R, C); const int Rb = (R & ~31) + perm32(R & 31);
        voffA[i] = (unsigned)(R * lda + C) * 2u; voffB[i] = (unsigned)(Rb * K + C) * 2u; }
    const size_t kstep = (size_t)(BK * 2);
    const size_t hstepA = (size_t)HALF * lda * 2, hstepB = (size_t)HALF * K * 2;
    const size_t tstepA = 2 * hstepA, tstepB = 2 * hstepB;
    const unsigned ldsw = (unsigned)wid * 1024u;
    const int aoff = lds_byte(wr * 64 + fr, fq * 8), boff = lds_byte(wc * 32 + fr, fq * 8);
#define PG8_SA(b, h) (((b) * 2 + (h)) * HTB)
#define PG8_SB(b, h) ((4 + (b) * 2 + (h)) * HTB)
#define PG8_STAGE(bufoff, gbase, voff) do { _Pragma("unroll") for (int _i = 0; _i < 2; ++_i) \
        __builtin_amdgcn_global_load_lds((const unsigned*)((const char*)(gbase) + (voff)[_i]), (LAS unsigned*)(lds + (bufoff) + ldsw + _i * 8192), 16, 0, 0); } while (0)
#define PG8_LDA(dst, b, h) do { _Pragma("unroll") for (int m = 0; m < 4; ++m) _Pragma("unroll") for (int k = 0; k < 2; ++k) dst[m][k] = *(const LAS bf16x8*)(lds + PG8_SA(b, h) + aoff + m * 2048 + k * 1024); } while (0)
#define PG8_LDB(dst, b, h) do { _Pragma("unroll") for (int n = 0; n < 2; ++n) _Pragma("unroll") for (int k = 0; k < 2; ++k) dst[n][k] = *(const LAS bf16x8*)(lds + PG8_SB(b, h) + boff + n * 2048 + k * 1024); } while (0)
#define PG8_MMA(ai, bj, At, Bt) do { __builtin_amdgcn_s_setprio(1); _Pragma("unroll") for (int m = 0; m < 4; ++m) _Pragma("unroll") for (int n = 0; n < 2; ++n) _Pragma("unroll") for (int k = 0; k < 2; ++k) \
        acc[ai][bj][m][n] = __builtin_amdgcn_mfma_f32_16x16x32_bf16(Bt[n][k], At[m][k], acc[ai][bj][m][n], 0, 0, 0); __builtin_amdgcn_s_setprio(0); } while (0)
#define PG8_WAIT_V(n) asm volatile("s_waitcnt vmcnt(" #n ")" ::: "memory")
#define PG8_WAIT_L(n) asm volatile("s_waitcnt lgkmcnt(" #n ")" ::: "memory")
#define PG8_BAR __builtin_amdgcn_s_barrier()
#define PG8_SCHED __builtin_amdgcn_sched_barrier(0)
    Unit cur, nxt; int ui = 0;
    if (!S.next(0, cur)) return;
    f32x4 acc[2][2][4][2];
#pragma unroll
    for (int a = 0; a < 2; ++a)
#pragma unroll
        for (int b = 0; b < 2; ++b)
#pragma unroll
            for (int m = 0; m < 4; ++m)
#pragma unroll
                for (int n = 0; n < 2; ++n) acc[a][b][m][n] = (f32x4){0.f, 0.f, 0.f, 0.f};
    bf16x8 At[4][2], B0[2][2], B1[2][2];
    const char* cA = (const char*)Ap + (size_t)cur.pm * tstepA; const char* cB = (const char*)Btp + (size_t)cur.pn * tstepB;
    PG8_STAGE(PG8_SB(0, 0), cB, voffB); PG8_STAGE(PG8_SA(0, 0), cA, voffA); PG8_STAGE(PG8_SB(0, 1), cB + hstepB, voffB); PG8_STAGE(PG8_SA(0, 1), cA + hstepA, voffA);
    if (wr == 1) PG8_BAR;
    PG8_WAIT_V(4); PG8_BAR;
    PG8_STAGE(PG8_SB(1, 0), cB + kstep, voffB); PG8_STAGE(PG8_SA(1, 0), cA + kstep, voffA); PG8_STAGE(PG8_SB(1, 1), cB + hstepB + kstep, voffB);
    PG8_WAIT_V(6); PG8_BAR;
    for (;;) {
        const bool has_next = S.next(ui + 1, nxt);
        const char* nA = has_next ? (const char*)Ap + (size_t)nxt.pm * tstepA : cA; const char* nB = has_next ? (const char*)Btp + (size_t)nxt.pn * tstepB : cB;
        for (int t = 0; t < nt; t += 2) {
            const bool last = (t == nt - 2);
            const char* a1 = cA + (size_t)(t + 1) * kstep;
            const char* a2 = last ? nA : cA + (size_t)(t + 2) * kstep; const char* b2 = last ? nB : cB + (size_t)(t + 2) * kstep;
            const char* a3 = a2 + kstep; const char* b3 = b2 + kstep;
            if constexpr (Epi::HOOK) {
                if (t == E.t1 || t == E.t2) {
                    const int which = (t == E.t1) ? 0 : 1;
                    const int t2 = otid(), w2 = t2 >> 6, l2 = t2 & 63;
                    const int rb = cur.pm * BM + (w2 >> 2) * 64 + (l2 & 15), cb = cur.pn * BM + (w2 & 3) * 32 + 8 * (l2 >> 4);
                    {   u32x4 rw[16];
#pragma unroll
                        for (int ai = 0; ai < 2; ++ai)
#pragma unroll
                            for (int m = 0; m < 4; ++m)
#pragma unroll
                                for (int bj = 0; bj < 2; ++bj) rw[8 * ai + 2 * m + bj] = E.ratio_raw(which, rb + ai * HALF + m * 16, cb + bj * HALF);
                        __builtin_amdgcn_sched_barrier(0);
#pragma unroll
                        for (int ai = 0; ai < 2; ++ai)
#pragma unroll
                            for (int m = 0; m < 4; ++m)
#pragma unroll
                                for (int bj = 0; bj < 2; ++bj) { f32x4 r0, r1; Epi::unpack(rw[8 * ai + 2 * m + bj], r0, r1); acc[ai][bj][m][0] *= r0; acc[ai][bj][m][1] *= r1; }
                        __builtin_amdgcn_sched_barrier(0);
                    }
                }
            }
            PG8_LDB(B0, 0, 0); PG8_SCHED; PG8_LDA(At, 0, 0); PG8_STAGE(PG8_SA(1, 1), a1 + hstepA, voffA);
            PG8_WAIT_L(8); PG8_BAR; PG8_WAIT_L(0); PG8_MMA(0, 0, At, B0); PG8_BAR; PG8_SCHED;
            PG8_LDB(B1, 0, 1); PG8_STAGE(PG8_SB(0, 0), b2, voffB);
            PG8_BAR; PG8_WAIT_L(0); PG8_MMA(0, 1, At, B1); PG8_BAR;
            PG8_LDA(At, 0, 1); PG8_STAGE(PG8_SA(0, 0), a2, voffA);
            PG8_BAR; PG8_WAIT_L(0); PG8_MMA(1, 0, At, B0); PG8_BAR; PG8_SCHED;
            PG8_STAGE(PG8_SB(0, 1), b2 + hstepB, voffB);
            PG8_WAIT_V(6); PG8_BAR; PG8_MMA(1, 1, At, B1); PG8_BAR;
            PG8_LDB(B0, 1, 0); PG8_SCHED; PG8_LDA(At, 1, 0); PG8_STAGE(PG8_SA(0, 1), a2 + hstepA, voffA);
            PG8_WAIT_L(8); PG8_BAR; PG8_WAIT_L(0); PG8_MMA(0, 0, At, B0); PG8_BAR; PG8_SCHED;
            PG8_LDB(B1, 1, 1); PG8_STAGE(PG8_SB(1, 0), b3, voffB);
            PG8_BAR; PG8_WAIT_L(0); PG8_MMA(0, 1, At, B1); PG8_BAR;
            PG8_LDA(At, 1, 1); PG8_STAGE(PG8_SA(1, 0), a3, voffA);
            PG8_BAR; PG8_WAIT_L(0); PG8_MMA(1, 0, At, B0); PG8_BAR; PG8_SCHED;
            PG8_STAGE(PG8_SB(1, 1), b3 + hstepB, voffB);
            PG8_WAIT_V(6); PG8_BAR; PG8_MMA(1, 1, At, B1); PG8_BAR;
        }
        {
            const int t2 = otid(), w2 = t2 >> 6, l2 = t2 & 63;
            const int rb = cur.pm * BM + (w2 >> 2) * 64 + (l2 & 15), cb = cur.pn * BM + (w2 & 3) * 32 + 8 * (l2 >> 4);
            if constexpr (Epi::NL == 0) {
#pragma unroll
                for (int ai = 0; ai < 2; ++ai)
#pragma unroll
                    for (int m = 0; m < 4; ++m)
#pragma unroll
                        for (int bj = 0; bj < 2; ++bj) E.store8(rb + ai * HALF + m * 16, cb + bj * HALF, acc[ai][bj][m][0], acc[ai][bj][m][1]);
            } else {
                constexpr int MG = Epi::NL <= 2 ? 4 : 2;
#pragma unroll
                for (int ai = 0; ai < 2; ++ai)
#pragma unroll
                    for (int m0 = 0; m0 < 4; m0 += MG) {
                        f32x4 ax[2 * MG][Epi::NL];
#pragma unroll
                        for (int mm = 0; mm < MG; ++mm)
#pragma unroll
                            for (int bj = 0; bj < 2; ++bj) E.aux(rb + ai * HALF + (m0 + mm) * 16, cb + bj * HALF, ax[2 * mm + bj]);
                        __builtin_amdgcn_sched_barrier(0);
#pragma unroll
                        for (int mm = 0; mm < MG; ++mm)
#pragma unroll
                            for (int bj = 0; bj < 2; ++bj) E.store8a(rb + ai * HALF + (m0 + mm) * 16, cb + bj * HALF, acc[ai][bj][m0 + mm][0], acc[ai][bj][m0 + mm][1], ax[2 * mm + bj]);
                        __builtin_amdgcn_sched_barrier(0);
                    }
            }
        }
        if (!has_next) break;
#pragma unroll
        for (int a = 0; a < 2; ++a)
#pragma unroll
            for (int b = 0; b < 2; ++b)
#pragma unroll
                for (int m = 0; m < 4; ++m)
#pragma unroll
                    for (int n = 0; n < 2; ++n) acc[a][b][m][n] = (f32x4){0.f, 0.f, 0.f, 0.f};
        cur = nxt; cA = nA; cB = nB; ++ui;
    }
    PG8_WAIT_V(0);
    if (wr == 0) PG8_BAR;
    PG8_BAR;
#undef PG8_SA
#undef PG8_SB
#undef PG8_STAGE
#undef PG8_LDA
#undef PG8_LDB
#undef PG8_MMA
#undef PG8_WAIT_V
#undef PG8_WAIT_L
#undef PG8_BAR
#undef PG8_SCHED
}

template <int NS, class Epi>
DEVI void gemm_skinny(const bf16_t* Ap, int lda, const bf16_t* Btp, int N, int K, int row_base, int fb, const Epi& E, int nb = 0) {
    constexpr int GPB = 8 / NS, NSEG = Epi::HOOK ? 3 : 1;
    LAS f32x4* red = (LAS f32x4*)(dyn_lds + 1024);
    const int tid = otid(), wid = tid >> 6, lane = tid & 63, fr = lane & 15, fq = lane >> 4;
    const int sub = wid / NS, sp = wid % NS, ngrp = N / 32, kper = K / NS, grid = ogrid();
    const int b0 = (obid() - fb + grid) % grid, nbk = nb > 0 ? nb : grid;
    for (int g0 = b0 < nbk ? b0 * GPB : ngrp; g0 < ngrp; g0 += nbk * GPB) {
        const int grp = g0 + sub; const bool on = grp < ngrp;
        f32x4 acc[NSEG][2][2];
#pragma unroll
        for (int sg = 0; sg < NSEG; ++sg)
#pragma unroll
            for (int m = 0; m < 2; ++m)
#pragma unroll
                for (int n = 0; n < 2; ++n) acc[sg][m][n] = (f32x4){0.f, 0.f, 0.f, 0.f};
        if (on) {
            const bf16_t* a0 = Ap + (size_t)fr * lda + 8 * fq;
            const bf16_t* a1 = Ap + (size_t)(16 + fr) * lda + 8 * fq;
            const bf16_t* b0p = Btp + (size_t)(grp * 32 + perm32(fr)) * K + 8 * fq;
            const bf16_t* b1p = Btp + (size_t)(grp * 32 + perm32(16 + fr)) * K + 8 * fq;
            const int kbeg = sp * kper, kend = kbeg + kper;
#pragma unroll
            for (int sg = 0; sg < NSEG; ++sg) {
                int lo = kbeg, hi = kend;
                if constexpr (Epi::HOOK) { const int s0 = sg == 0 ? 0 : sg == 1 ? E.t1 * BK : E.t2 * BK, s1 = sg == 0 ? E.t1 * BK : sg == 1 ? E.t2 * BK : K; lo = lo > s0 ? lo : s0; hi = hi < s1 ? hi : s1; }
#pragma unroll 8
                for (int k0 = lo; k0 < hi; k0 += 32) {
                    const bf16x8 fa0 = *(const bf16x8*)(a0 + k0), fa1 = *(const bf16x8*)(a1 + k0), fb0 = *(const bf16x8*)(b0p + k0), fb1 = *(const bf16x8*)(b1p + k0);
                    acc[sg][0][0] = __builtin_amdgcn_mfma_f32_16x16x32_bf16(fb0, fa0, acc[sg][0][0], 0, 0, 0);
                    acc[sg][0][1] = __builtin_amdgcn_mfma_f32_16x16x32_bf16(fb1, fa0, acc[sg][0][1], 0, 0, 0);
                    acc[sg][1][0] = __builtin_amdgcn_mfma_f32_16x16x32_bf16(fb0, fa1, acc[sg][1][0], 0, 0, 0);
                    acc[sg][1][1] = __builtin_amdgcn_mfma_f32_16x16x32_bf16(fb1, fa1, acc[sg][1][1], 0, 0, 0);
                }
            }
        }
        __syncthreads();
#pragma unroll
        for (int sg = 0; sg < NSEG; ++sg)
#pragma unroll
            for (int mn = 0; mn < 4; ++mn) red[((wid * NSEG + sg) * 4 + mn) * 64 + lane] = acc[sg][mn >> 1][mn & 1];
        __syncthreads();
        if (on && sp == 0) {
            f32x4 v[NSEG][4];
#pragma unroll
            for (int sg = 0; sg < NSEG; ++sg)
#pragma unroll
                for (int mn = 0; mn < 4; ++mn) { f32x4 t = red[(((sub * NS) * NSEG + sg) * 4 + mn) * 64 + lane];
#pragma unroll
                    for (int s2 = 1; s2 < NS; ++s2) t += red[(((sub * NS + s2) * NSEG + sg) * 4 + mn) * 64 + lane];
                    v[sg][mn] = t; }
#pragma unroll
            for (int m = 0; m < 2; ++m) {
                f32x4 x0 = v[0][2 * m], x1 = v[0][2 * m + 1];
                if constexpr (Epi::HOOK) { f32x4 r0, r1; E.ratio(0, row_base + 16 * m + fr, grp * 32 + 8 * fq, r0, r1); x0 = x0 * r0 + v[1][2 * m]; x1 = x1 * r1 + v[1][2 * m + 1];
                    E.ratio(1, row_base + 16 * m + fr, grp * 32 + 8 * fq, r0, r1); x0 = x0 * r0 + v[2][2 * m]; x1 = x1 * r1 + v[2][2 * m + 1]; }
                if constexpr (Epi::NL == 0) E.store8(row_base + 16 * m + fr, grp * 32 + 8 * fq, x0, x1);
                else { f32x4 ax[Epi::NL]; E.aux(row_base + 16 * m + fr, grp * 32 + 8 * fq, ax); E.store8a(row_base + 16 * m + fr, grp * 32 + 8 * fq, x0, x1, ax); }
            }
        }
    }
    __syncthreads();
}
}

using pg8::bf16_t; using pg8::f32x4; using pg8::u32x4; using pg8::u32x2; using pg8::cvt_pk_bf16;
DEVI bf16_t f2bf(float f) { unsigned u = __float_as_uint(f); u += 0x7FFFu + ((u >> 16) & 1u); return (bf16_t)(u >> 16); }
DEVI float fast_sigmoid(float x) { return __builtin_amdgcn_rcpf(1.0f + __expf(-x)); }
DEVI float neg_expm1_small(float x) {
    if (x > -0.3f) { const float p = 1.0f + x * (0.5f + x * (0.16666667f + x * (0.041666668f + x * (0.0083333338f + x * 0.0013888889f)))); return -x * p; }
    return 1.0f - __expf(x);
}
DEVI float fast_softplus(float x) { return fmaxf(x, 0.f) + __logf(1.0f + __expf(-fabsf(x))); }
namespace K { constexpr int NINP = 10496, WIN_SZ = NINP * 1024, WPR_SZ = 1024 * 3328, WO_SZ = 1024 * 1024, WFI_SZ = 5632 * 1024, WFO_SZ = 1024 * 2816; }

namespace K { constexpr int UC_RY = 1280, UC_QKV = 2560, UC_GZ = 5632, UC_SM = 9728, USMW = 688, SM_A = 0, SM_B = 8, SM_MQ = 16, SM_MKV = 400; }
DEVI float fast_gelu_tanh(float x) { const float u = 1.5957691216057308f * (x + 0.044715f * x * x * x); return x * __builtin_amdgcn_rcpf(1.0f + __expf(-u)); }
struct EpiU { static constexpr bool HOOK = false; static constexpr int NL = 0; bf16_t* URX; bf16_t* GY; bf16_t* UQKV; bf16_t* SZ; bf16_t* R1; bf16_t* R2; bf16_t* R3; float* USM;
    DEVI void store8(int row, int col0, f32x4 v0, f32x4 v1) const {
        using namespace K;
        if (col0 < UC_GZ) {
            u32x4 w; w.x = cvt_pk_bf16(v0[0], v0[1]); w.y = cvt_pk_bf16(v0[2], v0[3]); w.z = cvt_pk_bf16(v1[0], v1[1]); w.w = cvt_pk_bf16(v1[2], v1[3]);
            bf16_t* dst = col0 < UC_RY ? URX + (size_t)row * DRNN + col0 : col0 < UC_QKV ? GY + (size_t)row * DRNN + (col0 - UC_RY) : UQKV + (size_t)row * GC + (col0 - UC_QKV);
            *(u32x4*)dst = w;
        } else if (col0 < UC_SM) {
            const size_t o = (size_t)row * D + ((col0 - UC_GZ) >> 2);
            const float ea0 = __expf(-v0[0]), ea1 = __expf(-v0[1]), eb0 = __expf(-v0[2]), eb1 = __expf(-v0[3]), ec0 = __expf(-v1[0]), ec1 = __expf(-v1[1]);
            const float ia0 = __builtin_amdgcn_rcpf(1.0f + ea0), ia1 = __builtin_amdgcn_rcpf(1.0f + ea1), ib0 = __builtin_amdgcn_rcpf(1.0f + eb0), ib1 = __builtin_amdgcn_rcpf(1.0f + eb1), ic0 = __builtin_amdgcn_rcpf(1.0f + ec0), ic1 = __builtin_amdgcn_rcpf(1.0f + ec1);
            *(unsigned*)(R1 + o) = cvt_pk_bf16((1.0f + eb0) * ia0, (1.0f + eb1) * ia1);
            *(unsigned*)(R2 + o) = cvt_pk_bf16((1.0f + ec0) * ib0, (1.0f + ec1) * ib1);
            *(unsigned*)(R3 + o) = cvt_pk_bf16(ic0, ic1);
            *(unsigned*)(SZ + o) = cvt_pk_bf16(v1[2], v1[3]);
        } else if (col0 < NIN) {
            u32x4 w; w.x = cvt_pk_bf16(v0[0], v0[1]); w.y = cvt_pk_bf16(v0[2], v0[3]); w.z = cvt_pk_bf16(v1[0], v1[1]); w.w = cvt_pk_bf16(v1[2], v1[3]);
            *(u32x4*)((bf16_t*)USM + (size_t)row * USMW + (col0 - UC_SM)) = w;
        }
    } };
struct EpiF32 { static constexpr bool HOOK = false; static constexpr int NL = 0; float* C; int ldc;
    DEVI void store8(int row, int col0, f32x4 v0, f32x4 v1) const { float* p = C + (size_t)row * ldc + col0; *(f32x4*)p = v0; *(f32x4*)(p + 4) = v1; } };
struct EpiBf16 { static constexpr bool HOOK = false; static constexpr int NL = 0; bf16_t* C; int ldc;
    DEVI void store8(int row, int col0, f32x4 v0, f32x4 v1) const { u32x4 w; w.x = cvt_pk_bf16(v0[0], v0[1]); w.y = cvt_pk_bf16(v0[2], v0[3]); w.z = cvt_pk_bf16(v1[0], v1[1]); w.w = cvt_pk_bf16(v1[2], v1[3]);
        *(u32x4*)(C + (size_t)row * ldc + col0) = w; } };
struct EpiK { static constexpr bool HOOK = false; static constexpr int NL = 0; bf16_t* Kb;
    DEVI void store8(int row, int col0, f32x4 v0, f32x4 v1) const { u32x4 w; w.x = cvt_pk_bf16(v0[0], v0[1]); w.y = cvt_pk_bf16(v0[2], v0[3]); w.z = cvt_pk_bf16(v1[0], v1[1]); w.w = cvt_pk_bf16(v1[2], v1[3]);
        *(u32x4*)(Kb + (size_t)row * 768 + (col0 >> 6) * 96 + (col0 & 63)) = w; } };
struct EpiQ { static constexpr bool HOOK = false; static constexpr int NL = 2; bf16_t* Qb; const float* ROT;
    DEVI void aux(int row, int col0, f32x4* a) const { const int h = col0 / 96, d0 = col0 - 96 * h; const float* cs = ROT + (size_t)(pslot_of_row(row) * 16 + (d0 >= 64 ? (d0 - 64) >> 1 : 0)) * 2;
        a[0] = *(const f32x4*)cs; a[1] = *(const f32x4*)(cs + 4); }
    DEVI void store8a(int row, int col0, f32x4 v0, f32x4 v1, const f32x4* a) const {
        const int h = col0 / 96, d0 = col0 - 96 * h; float o[8] = {v0[0], v0[1], v0[2], v0[3], v1[0], v1[1], v1[2], v1[3]};
        if (d0 >= 64) { const float cs[8] = {a[0][0], a[0][1], a[0][2], a[0][3], a[1][0], a[1][1], a[1][2], a[1][3]};
#pragma unroll
            for (int k = 0; k < 4; ++k) { const float c = cs[2 * k], sn = cs[2 * k + 1], x1 = o[2 * k], x2 = o[2 * k + 1]; o[2 * k] = x1 * c - x2 * sn; o[2 * k + 1] = x2 * c + x1 * sn; } }
        const float sc = 0.10206207261596577f * 1.4426950408889634f;
        u32x4 w; w.x = cvt_pk_bf16(o[0] * sc, o[1] * sc); w.y = cvt_pk_bf16(o[2] * sc, o[3] * sc); w.z = cvt_pk_bf16(o[4] * sc, o[5] * sc); w.w = cvt_pk_bf16(o[6] * sc, o[7] * sc);
        *(u32x4*)(Qb + (size_t)row * 768 + col0) = w; } };
struct EpiProj { static constexpr bool HOOK = true; static constexpr int NL = 1; int t1, t2; const bf16_t* R1; const bf16_t* R2; const bf16_t* R3; bf16_t* M;
    static DEVI void unpack(u32x4 w, f32x4& r0, f32x4& r1) { r0[0] = __uint_as_float(w.x << 16); r0[1] = __uint_as_float(w.x & 0xffff0000u); r0[2] = __uint_as_float(w.y << 16); r0[3] = __uint_as_float(w.y & 0xffff0000u);
        r1[0] = __uint_as_float(w.z << 16); r1[1] = __uint_as_float(w.z & 0xffff0000u); r1[2] = __uint_as_float(w.w << 16); r1[3] = __uint_as_float(w.w & 0xffff0000u); }
    DEVI void ratio(int which, int row, int col0, f32x4& r0, f32x4& r1) const { const u32x4 w = *(const u32x4*)((which == 0 ? R1 : R2) + (size_t)row * 1024 + col0); unpack(w, r0, r1); }
    DEVI u32x4 ratio_raw(int which, int row, int col0) const { return *(const u32x4*)((which == 0 ? R1 : R2) + (size_t)row * 1024 + col0); }
    DEVI void aux(int row, int col0, f32x4* a) const { const u32x4 w = *(const u32x4*)(R3 + (size_t)row * 1024 + col0); a[0] = (f32x4){__uint_as_float(w.x), __uint_as_float(w.y), __uint_as_float(w.z), __uint_as_float(w.w)}; }
    DEVI void store8a(int row, int col0, f32x4 v0, f32x4 v1, const f32x4* a) const { u32x4 rw = {__float_as_uint(a[0][0]), __float_as_uint(a[0][1]), __float_as_uint(a[0][2]), __float_as_uint(a[0][3])}; f32x4 r0, r1; unpack(rw, r0, r1); v0 *= r0; v1 *= r1;
        u32x4 w; w.x = cvt_pk_bf16(v0[0], v0[1]); w.y = cvt_pk_bf16(v0[2], v0[3]); w.z = cvt_pk_bf16(v1[0], v1[1]); w.w = cvt_pk_bf16(v1[2], v1[3]); *(u32x4*)(M + (size_t)row * 1024 + col0) = w; } };
struct EpiRes { static constexpr bool HOOK = false; static constexpr int NL = 4; const float* xi; const float* xis; float* xo; const float* modchunk; int xi_bf, xo_bf;
    DEVI void aux(int row, int col0, f32x4* a) const { const float* g = modchunk + (size_t)cond_of_row(row) * 6 * K::D + col0;
        if (xi_bf) { const u32x4 w = *(const u32x4*)((const bf16_t*)xi + (size_t)row * K::D + col0); a[0] = (f32x4){__uint_as_float(w.x), __uint_as_float(w.y), __uint_as_float(w.z), __uint_as_float(w.w)}; a[1] = a[0]; }
        else { const float* x = (row < K::NP ? xi : xis) + (size_t)row * K::D + col0; a[0] = *(const f32x4*)x; a[1] = *(const f32x4*)(x + 4); }
        a[2] = *(const f32x4*)g; a[3] = *(const f32x4*)(g + 4); }
    DEVI void store8a(int row, int col0, f32x4 v0, f32x4 v1, const f32x4* a) const {
        f32x4 x0 = a[0], x1 = a[1];
        if (xi_bf) { const unsigned w0 = __float_as_uint(a[0][0]), w1 = __float_as_uint(a[0][1]), w2 = __float_as_uint(a[0][2]), w3 = __float_as_uint(a[0][3]);
            x0 = (f32x4){__uint_as_float(w0 << 16), __uint_as_float(w0 & 0xffff0000u), __uint_as_float(w1 << 16), __uint_as_float(w1 & 0xffff0000u)};
            x1 = (f32x4){__uint_as_float(w2 << 16), __uint_as_float(w2 & 0xffff0000u), __uint_as_float(w3 << 16), __uint_as_float(w3 & 0xffff0000u)}; }
        const f32x4 r0 = x0 + a[2] * v0, r1 = x1 + a[3] * v1;
        if (xo_bf) { u32x4 w; w.x = cvt_pk_bf16(r0[0], r0[1]); w.y = cvt_pk_bf16(r0[2], r0[3]); w.z = cvt_pk_bf16(r1[0], r1[1]); w.w = cvt_pk_bf16(r1[2], r1[3]); *(u32x4*)((bf16_t*)xo + (size_t)row * K::D + col0) = w; }
        else { float* o = xo + (size_t)row * K::D + col0; *(f32x4*)o = r0; *(f32x4*)(o + 4) = r1; } } };
struct EpiFfnIn { static constexpr bool HOOK = false; static constexpr int NL = 0; bf16_t* ACT;
    DEVI void store8(int row, int col0, f32x4 v0, f32x4 v1) const { float a[4];
#pragma unroll
        for (int i = 0; i < 4; ++i) a[i] = v0[i] * fast_sigmoid(v0[i]) * v1[i];
        u32x2 w; w.x = cvt_pk_bf16(a[0], a[1]); w.y = cvt_pk_bf16(a[2], a[3]); *(u32x2*)(ACT + (size_t)row * K::DFF + (col0 >> 1)) = w; } };

struct ConvCtx { int rot, vb, vgrid; };
template <class ColMap, class VecTile>
DEVI void conv_wT(ConvCtx& cx, const float* src, int ldsrc, int Ksrc, bf16_t* dst, int ldd, int koff, int Npad, ColMap cm, VecTile vt) {
    LAS unsigned short* T = (LAS unsigned short*)(dyn_lds + 1024);
    const int tid = otid(), grid = cx.vgrid, bid = (cx.vb - cx.rot + grid) % grid;
    const int tk = Ksrc / 64, tn = Npad / 64, nt = tk * tn;
    cx.rot = (cx.rot + nt) % grid;
    const int kk = tid >> 3, ng = (tid & 7) * 8, nn = tid >> 3, k8 = (tid & 7) * 8;
    float va[8], vb[8];
    auto ld = [&](int t, float* v) { const int n0 = (t / tk) * 64, k0 = (t % tk) * 64; const float* sp = src + (size_t)(k0 + kk) * ldsrc;
        if (vt(n0)) { const int s0 = cm(n0 + ng), s1 = cm(n0 + ng + 4);
            const float4 a = s0 >= 0 ? *(const float4*)(sp + s0) : make_float4(0.f, 0.f, 0.f, 0.f), b = s1 >= 0 ? *(const float4*)(sp + s1) : make_float4(0.f, 0.f, 0.f, 0.f);
            v[0] = a.x; v[1] = a.y; v[2] = a.z; v[3] = a.w; v[4] = b.x; v[5] = b.y; v[6] = b.z; v[7] = b.w; }
        else {
#pragma unroll
            for (int e = 0; e < 8; ++e) { const int sc = cm(n0 + ng + e); v[e] = sc >= 0 ? sp[sc] : 0.f; } } };
    if (bid < nt) ld(bid, va);
    if (bid + grid < nt) ld(bid + grid, vb);
    for (int t = bid; t < nt; t += 2 * grid) {
        const bool two = t + grid < nt;
#pragma unroll
        for (int e = 0; e < 8; ++e) T[(ng + e) * 72 + kk] = f2bf(va[e]);
        if (two) {
#pragma unroll
            for (int e = 0; e < 8; ++e) T[64 * 72 + (ng + e) * 72 + kk] = f2bf(vb[e]); }
        if (t + 2 * grid < nt) ld(t + 2 * grid, va);
        if (t + 3 * grid < nt) ld(t + 3 * grid, vb);
        lds_barrier();
        { const int n0 = (t / tk) * 64, k0 = (t % tk) * 64; const u32x4 w = *(const LAS u32x4*)(T + nn * 72 + k8); *(u32x4*)(dst + (size_t)(n0 + nn) * ldd + koff + k0 + k8) = w; }
        if (two) { const int t2 = t + grid, n0 = (t2 / tk) * 64, k0 = (t2 % tk) * 64; const u32x4 w = *(const LAS u32x4*)(T + 64 * 72 + nn * 72 + k8); *(u32x4*)(dst + (size_t)(n0 + nn) * ldd + koff + k0 + k8) = w; }
        lds_barrier();
    }
}
NOINL void ph_convert(ConvCtx& rot, int l, int part) {
    using namespace K;
    if (part == 0) {
        conv_wT(rot, uni(PRM.w_in) + (size_t)l * D * NIN, NIN, D, uni(PRM.WIN) + (size_t)l * WIN_SZ, D, 0, NINP, [](int n) {
            if (n < UC_GZ) return n;
            if (n < UC_SM) { const int q = n - UC_GZ, d = 2 * (q >> 3) + (q & 1), g = (q & 7) >> 1; return g == 0 ? U_GATE + d : g == 1 ? U_GATE + D + d : g == 2 ? U_GATE + 2 * D + d : U_Z + d; }
            return n < NIN ? U_A + (n - UC_SM) : -1; }, [](int n0) { return n0 < UC_GZ || n0 >= UC_SM; });
        conv_wT(rot, uni(PRM.w_rg_proj) + (size_t)l * DRNN * D, D, DRNN, uni(PRM.WPR) + (size_t)l * WPR_SZ, CATW, CAT_RG, D, [](int n) { return n; }, [](int) { return true; });
        conv_wT(rot, uni(PRM.w_gdn_proj) + (size_t)l * GVW * D, D, GVW, uni(PRM.WPR) + (size_t)l * WPR_SZ, CATW, CAT_GDN, D, [](int n) { return n; }, [](int) { return true; });
        conv_wT(rot, uni(PRM.w_mla_proj) + (size_t)l * 1024 * D, D, 1024, uni(PRM.WPR) + (size_t)l * WPR_SZ, CATW, CAT_MLA, D, [](int n) { return n; }, [](int) { return true; });
        conv_wT(rot, uni(PRM.w_o) + (size_t)l * D * D, D, D, uni(PRM.WO) + (size_t)l * WO_SZ, D, 0, D, [](int n) { return n; }, [](int) { return true; });
    } else {
        conv_wT(rot, uni(PRM.w_ffn_in) + (size_t)l * D * 2 * DFF, 2 * DFF, D, uni(PRM.WFI) + (size_t)l * WFI_SZ, D, 0, 2 * DFF, [](int n) { const int j = n >> 3, e = n & 7; return e < 4 ? 4 * j + e : DFF + 4 * j + (e - 4); }, [](int) { return true; });
        conv_wT(rot, uni(PRM.w_ffn_out) + (size_t)l * DFF * D, D, DFF, uni(PRM.WFO) + (size_t)l * WFO_SZ, DFF, 0, D, [](int n) { return n; }, [](int) { return true; });
        conv_wT(rot, uni(PRM.w_uq) + (size_t)l * QL * 768, 768, QL, uni(PRM.WUQ) + (size_t)l * 768 * QL, QL, 0, 768, [](int n) { return n; }, [](int) { return true; });
        conv_wT(rot, uni(PRM.w_uq) + (size_t)l * QL * 768, 768, QL, uni(PRM.WUQP) + (size_t)l * 768 * QL, QL, 0, 768,
                [](int n) { const int h = n / 96, d = n - 96 * h; return d < 64 ? n : h * 96 + 64 + ((d - 64) >> 1) + 16 * ((d - 64) & 1); }, [](int) { return false; });
        conv_wT(rot, uni(PRM.w_ukv) + (size_t)l * KVL * 1536, 1536, KVL, uni(PRM.WK) + (size_t)l * 512 * KVL, KVL, 0, 512, [](int n) { return (n >> 6) * 192 + (n & 63); }, [](int) { return true; });
        conv_wT(rot, uni(PRM.w_ukv) + (size_t)l * KVL * 1536, 1536, KVL, uni(PRM.WV) + (size_t)l * 1024 * KVL, KVL, 0, 1024, [](int n) { return (n >> 7) * 192 + 64 + (n & 127); }, [](int) { return true; });
        for (int n = 0; n < RGN; ++n) {
            conv_wT(rot, uni(PRM.rg_wa) + ((size_t)l * RGN + n) * RGB * RGB, RGB, RGB, uni(PRM.WRG) + ((size_t)l * RGN + n) * 256 * 128, RGB, 0, RGB, [](int c) { return c; }, [](int) { return true; });
            conv_wT(rot, uni(PRM.rg_wx) + ((size_t)l * RGN + n) * RGB * RGB, RGB, RGB, uni(PRM.WRG) + ((size_t)l * RGN + n) * 256 * 128 + 128 * 128, RGB, 0, RGB, [](int c) { return c; }, [](int) { return true; });
        }
    }
}

template <class Epi>
DEVI void gemm_f32(const float* __restrict__ A, int lda, int M, const float* __restrict__ B, int ldb, int N, int Kd, float* lds, Epi epi) {
    float* As = lds; float* Bs = lds + 16 * 132;
    const int tid = otid(), tx = tid & 31, ty = tid >> 5;
    const int tm = (M + 127) / 128, tn = (N + 127) / 128, ntiles = tm * tn;
    const int ar = tid >> 2, ak = (tid & 3) * 4, bk = tid >> 5, bc = (tid & 31) * 4;
    const int bid_ = obid(), grid_ = ogrid();
    for (int tile = bid_; tile < ntiles; tile += grid_) {
        const int pm = tile / tn, pn = tile % tn, row0 = pm * 128, col0 = pn * 128;
        float acc[8][4];
#pragma unroll
        for (int i = 0; i < 8; ++i)
#pragma unroll
            for (int j = 0; j < 4; ++j) acc[i][j] = 0.f;
        for (int k0 = 0; k0 < Kd; k0 += 16) {
            float4 av = make_float4(0.f, 0.f, 0.f, 0.f), bv = make_float4(0.f, 0.f, 0.f, 0.f);
            if (row0 + ar < M) av = *(const float4*)(A + (size_t)(row0 + ar) * lda + k0 + ak);
            if (col0 + bc < N) bv = *(const float4*)(B + (size_t)(k0 + bk) * ldb + col0 + bc);
            __syncthreads();
            As[(ak + 0) * 132 + ar] = av.x; As[(ak + 1) * 132 + ar] = av.y; As[(ak + 2) * 132 + ar] = av.z; As[(ak + 3) * 132 + ar] = av.w;
            *(float4*)(Bs + bk * 128 + bc) = bv;
            __syncthreads();
#pragma unroll
            for (int kk = 0; kk < 16; ++kk) {
                const float4 a0 = *(const float4*)(As + kk * 132 + ty * 8), a1 = *(const float4*)(As + kk * 132 + ty * 8 + 4);
                const float4 b = *(const float4*)(Bs + kk * 128 + tx * 4);
                const float a[8] = {a0.x, a0.y, a0.z, a0.w, a1.x, a1.y, a1.z, a1.w};
                const float bb[4] = {b.x, b.y, b.z, b.w};
#pragma unroll
                for (int i = 0; i < 8; ++i)
#pragma unroll
                    for (int j = 0; j < 4; ++j) acc[i][j] = fmaf(a[i], bb[j], acc[i][j]);
            }
        }
#pragma unroll
        for (int i = 0; i < 8; ++i) {
            const int row = row0 + ty * 8 + i;
            if (row < M) {
#pragma unroll
                for (int j = 0; j < 4; ++j) { const int col = col0 + tx * 4 + j; if (col < N) epi(row, col, acc[i][j]); }
            }
        }
    }
    __syncthreads();
}

typedef float f32x16 __attribute__((ext_vector_type(16)));
namespace at { constexpr int KROW = 208, VROW = 144, KBUF = 64 * KROW, VBUF = 128 * VROW, VOFF = 2 * KBUF; }
DEVI void attn_prompt_block(const bf16_t* Qb, const bf16_t* Kb, const bf16_t* Vt, bf16_t* CAT, int b, int h, int qb, int tid) {
    using namespace K; using namespace at;
    LAS unsigned char* lds = (LAS unsigned char*)(dyn_lds + 1024);
    const int lane = tid & 63, w = tid >> 6, r = lane & 31, hi = lane >> 5;
    const int q0 = qb * 256 + w * 32, qpos = q0 + r;
    const int ntile = qb * 4 + 4;
    const int kc0 = tid, kc1 = 512 + tid; const bool k1on = tid < 256;
    const int kk0 = kc0 / 12, kp0 = kc0 - 12 * kk0, kk1 = kc1 / 12, kp1 = kc1 - 12 * kk1;
    const unsigned kg0 = (unsigned)((b * SEQ + kk0) * 768 + h * 96 + kp0 * 8);
    const unsigned kg1 = (unsigned)((b * SEQ + (k1on ? kk1 : 0)) * 768 + h * 96 + kp1 * 8);
    const int ve0 = tid >> 3, vp = tid & 7;
    const unsigned vg0 = (unsigned)((h * 128 + ve0) * NP + b * SEQ + vp * 8), vg1 = vg0 + 64u * NP;
    const int ksl0 = kk0 * KROW + kp0 * 16, ksl1 = kk1 * KROW + kp1 * 16, vsl0 = VOFF + ve0 * VROW + vp * 16, vsl1 = vsl0 + 64 * VROW;
    pg8::bf16x8 qf[6];
    { const bf16_t* qp = Qb + (size_t)(b * SEQ + qpos) * 768 + h * 96 + 8 * hi;
#pragma unroll
      for (int ks = 0; ks < 6; ++ks) qf[ks] = *(const pg8::bf16x8*)(qp + 16 * ks); }
    f32x16 O[4];
#pragma unroll
    for (int eb = 0; eb < 4; ++eb)
#pragma unroll
        for (int i = 0; i < 16; ++i) O[eb][i] = 0.f;
    float m = -1e30f, l = 0.f;
    u32x4 sk0, sk1 = {0u, 0u, 0u, 0u}, sv0, sv1;
    sk0 = *(const u32x4*)(Kb + kg0); if (k1on) sk1 = *(const u32x4*)(Kb + kg1); sv0 = *(const u32x4*)(Vt + vg0); sv1 = *(const u32x4*)(Vt + vg1);
    __syncthreads();
    *(LAS u32x4*)(lds + ksl0) = sk0; if (k1on) *(LAS u32x4*)(lds + ksl1) = sk1; *(LAS u32x4*)(lds + vsl0) = sv0; *(LAS u32x4*)(lds + vsl1) = sv1;
    __syncthreads();
    for (int j = 0; j < ntile; ++j) {
        const int k0 = j * 64, kbo = (j & 1) * KBUF, vbo = VOFF + (j & 1) * VBUF;
        const bool more = j + 1 < ntile;
        if (more) { const unsigned ko = (unsigned)(k0 + 64) * 768u; sk0 = *(const u32x4*)(Kb + (kg0 + ko)); if (k1on) sk1 = *(const u32x4*)(Kb + (kg1 + ko));
                    sv0 = *(const u32x4*)(Vt + (vg0 + (unsigned)(k0 + 64))); sv1 = *(const u32x4*)(Vt + (vg1 + (unsigned)(k0 + 64))); }
        if (k0 <= q0 + 31) {
            f32x16 p0, p1;
#pragma unroll
            for (int i = 0; i < 16; ++i) { p0[i] = 0.f; p1[i] = 0.f; }
            {   pg8::bf16x8 ka0[6], ka1[6];
#pragma unroll
                for (int ks = 0; ks < 6; ++ks) { ka0[ks] = *(const LAS pg8::bf16x8*)(lds + kbo + r * KROW + ks * 32 + hi * 16); ka1[ks] = *(const LAS pg8::bf16x8*)(lds + kbo + (32 + r) * KROW + ks * 32 + hi * 16); }
                __builtin_amdgcn_sched_barrier(0);
#pragma unroll
                for (int ks = 0; ks < 6; ++ks) { p0 = __builtin_amdgcn_mfma_f32_32x32x16_bf16(ka0[ks], qf[ks], p0, 0, 0, 0); p1 = __builtin_amdgcn_mfma_f32_32x32x16_bf16(ka1[ks], qf[ks], p1, 0, 0, 0); }
                __builtin_amdgcn_sched_barrier(0);
            }
            if (k0 + 63 > q0) {
                const int dq = qpos - k0 - 4 * hi;
#pragma unroll
                for (int i = 0; i < 16; ++i) { const int c = (i & 3) + 8 * (i >> 2); if (c > dq) p0[i] = -INFINITY; if (c + 32 > dq) p1[i] = -INFINITY; }
            }
            float mx = p0[0];
#pragma unroll
            for (int i = 1; i < 16; ++i) mx = fmaxf(mx, p0[i]);
#pragma unroll
            for (int i = 0; i < 16; ++i) mx = fmaxf(mx, p1[i]);
            mx = fmaxf(mx, shx(mx, 32, lane));
            const float mn = mx > m + 8.0f ? mx : m;
            if (__builtin_amdgcn_ballot_w64(mn != m) != 0ull) {
                const float alpha = __builtin_amdgcn_exp2f(m - mn); m = mn; l *= alpha;
#pragma unroll
                for (int eb = 0; eb < 4; ++eb)
#pragma unroll
                    for (int i = 0; i < 16; ++i) O[eb][i] *= alpha;
            }
            float ps = 0.f;
#pragma unroll
            for (int i = 0; i < 16; ++i) { p0[i] = __builtin_amdgcn_exp2f(p0[i] - mn); p1[i] = __builtin_amdgcn_exp2f(p1[i] - mn); ps += p0[i] + p1[i]; }
            ps += shx(ps, 32, lane);
            l += ps;
            pg8::bf16x8 pf[4];
            { u32x4 t;
              t.x = cvt_pk_bf16(p0[0], p0[1]); t.y = cvt_pk_bf16(p0[2], p0[3]); t.z = cvt_pk_bf16(p0[4], p0[5]); t.w = cvt_pk_bf16(p0[6], p0[7]); pf[0] = *(pg8::bf16x8*)&t;
              t.x = cvt_pk_bf16(p0[8], p0[9]); t.y = cvt_pk_bf16(p0[10], p0[11]); t.z = cvt_pk_bf16(p0[12], p0[13]); t.w = cvt_pk_bf16(p0[14], p0[15]); pf[1] = *(pg8::bf16x8*)&t;
              t.x = cvt_pk_bf16(p1[0], p1[1]); t.y = cvt_pk_bf16(p1[2], p1[3]); t.z = cvt_pk_bf16(p1[4], p1[5]); t.w = cvt_pk_bf16(p1[6], p1[7]); pf[2] = *(pg8::bf16x8*)&t;
              t.x = cvt_pk_bf16(p1[8], p1[9]); t.y = cvt_pk_bf16(p1[10], p1[11]); t.z = cvt_pk_bf16(p1[12], p1[13]); t.w = cvt_pk_bf16(p1[14], p1[15]); pf[3] = *(pg8::bf16x8*)&t; }
#pragma unroll
            for (int sh = 0; sh < 2; ++sh) {
                u32x2 vlo[2][4], vhi[2][4];
#pragma unroll
                for (int s2 = 0; s2 < 2; ++s2)
#pragma unroll
                    for (int eb = 0; eb < 4; ++eb) { const LAS unsigned char* vp_ = lds + vbo + (32 * eb + r) * VROW + (16 * (2 * sh + s2) + 4 * hi) * 2; vlo[s2][eb] = *(const LAS u32x2*)vp_; vhi[s2][eb] = *(const LAS u32x2*)(vp_ + 16); }
                __builtin_amdgcn_sched_barrier(0);
#pragma unroll
                for (int s2 = 0; s2 < 2; ++s2)
#pragma unroll
                    for (int eb = 0; eb < 4; ++eb) { u32x4 t; t.x = vlo[s2][eb].x; t.y = vlo[s2][eb].y; t.z = vhi[s2][eb].x; t.w = vhi[s2][eb].y;
                        O[eb] = __builtin_amdgcn_mfma_f32_32x32x16_bf16(*(pg8::bf16x8*)&t, pf[2 * sh + s2], O[eb], 0, 0, 0); }
                __builtin_amdgcn_sched_barrier(0);
            }
        }
        if (more) { const int nb = ((j + 1) & 1); *(LAS u32x4*)(lds + nb * KBUF + ksl0) = sk0; if (k1on) *(LAS u32x4*)(lds + nb * KBUF + ksl1) = sk1;
                    *(LAS u32x4*)(lds + nb * VBUF + vsl0) = sv0; *(LAS u32x4*)(lds + nb * VBUF + vsl1) = sv1; }
        __syncthreads();
    }
    const float il = 1.0f / l;
    bf16_t* op = CAT + (size_t)(b * SEQ + qpos) * CATW + CAT_MLA + h * 128 + 4 * hi;
#pragma unroll
    for (int eb = 0; eb < 4; ++eb)
#pragma unroll
        for (int g = 0; g < 4; ++g) { u32x2 t; t.x = cvt_pk_bf16(O[eb][4 * g] * il, O[eb][4 * g + 1] * il); t.y = cvt_pk_bf16(O[eb][4 * g + 2] * il, O[eb][4 * g + 3] * il);
            *(u32x2*)(op + 32 * eb + 8 * g) = t; }
}

NOINL void ph_gdn_sample(int layer, int u0, int ust) {
    using namespace K;
    const int tid = otid();
    if (tid >= 256) return;
    const int j = tid >> 1, hf = tid & 1, lane = tid & 63; const int bid_ = obid(), grid_ = ogrid();
    const float* stS = uni(PRM.state_gdn_S); const float* GB = uni(PRM.GB); const float* QKVC = uni(PRM.QKVC); float* OG = uni(PRM.OG); float* out = uni(PRM.out);
    for (int unit = BP * GH + u0; unit < (BP + BS) * GH; unit += ust) {
        const int seq = unit >> 3, h = unit & 7;
        const bool prompt = seq < BP;
        const int T = prompt ? SEQ : 1, row0 = prompt ? seq * SEQ : NP + (seq - BP);
        float S[64];
        if (prompt) {
#pragma unroll
            for (int d = 0; d < 64; ++d) S[d] = 0.f;
        } else {
            const float* sp = stS + ((size_t)(layer * BS + (seq - BP)) * GH + h) * GDK * GDV + (size_t)(hf * 64) * GDV + j;
#pragma unroll
            for (int d = 0; d < 64; ++d) S[d] = sp[(size_t)d * GDV];
        }
        for (int t = 0; t < T; ++t) {
            const int row = row0 + t;
            const float g = GB[(size_t)row * 16 + h], beta = GB[(size_t)row * 16 + 8 + h], eg = __expf(g);
            const float4* qv = (const float4*)(QKVC + (size_t)row * GC + h * 128 + hf * 64);
            const float4* kv = (const float4*)(QKVC + (size_t)row * GC + GKW + h * 128 + hf * 64);
            const float v = QKVC[(size_t)row * GC + 2 * GKW + h * 128 + j];
            float dot = 0.f;
#pragma unroll
            for (int d4 = 0; d4 < 16; ++d4) {
                const float4 k4 = kv[d4];
                S[4 * d4 + 0] *= eg; S[4 * d4 + 1] *= eg; S[4 * d4 + 2] *= eg; S[4 * d4 + 3] *= eg;
                dot = fmaf(S[4 * d4 + 0], k4.x, dot); dot = fmaf(S[4 * d4 + 1], k4.y, dot); dot = fmaf(S[4 * d4 + 2], k4.z, dot); dot = fmaf(S[4 * d4 + 3], k4.w, dot);
            }
            dot += shx(dot, 1, lane);
            const float u = beta * (v - dot);
            float o = 0.f;
#pragma unroll
            for (int d4 = 0; d4 < 16; ++d4) {
                const float4 k4 = kv[d4], q4 = qv[d4];
                S[4 * d4 + 0] = fmaf(k4.x, u, S[4 * d4 + 0]); S[4 * d4 + 1] = fmaf(k4.y, u, S[4 * d4 + 1]); S[4 * d4 + 2] = fmaf(k4.z, u, S[4 * d4 + 2]); S[4 * d4 + 3] = fmaf(k4.w, u, S[4 * d4 + 3]);
                o = fmaf(S[4 * d4 + 0], q4.x, o); o = fmaf(S[4 * d4 + 1], q4.y, o); o = fmaf(S[4 * d4 + 2], q4.z, o); o = fmaf(S[4 * d4 + 3], q4.w, o);
            }
            o += shx(o, 1, lane);
            if (hf == 0) ((bf16_t*)OG)[(size_t)row * GVW + h * 128 + j] = f2bf(o);
        }
        float* so = (prompt ? out + O_GSP + ((size_t)(layer * BP + seq) * GH + h) * GDK * GDV
                            : out + O_GSS + ((size_t)(layer * BS + (seq - BP)) * GH + h) * GDK * GDV) + (size_t)(hf * 64) * GDV + j;
#pragma unroll
        for (int d = 0; d < 64; ++d) so[(size_t)d * GDV] = S[d];
    }
}

namespace gd { constexpr int NCH = 2048, UT_SZ = 128 * 64, WT_SZ = 64 * 128, KDT_SZ = 128 * 64, AQ_SZ = 64 * 64;
    constexpr int WROW = 272, KROW = 144, AROW = 144, B_WT = 0, B_QG = 64 * WROW, B_KD = 2 * 64 * WROW, B_AQ = B_KD + 128 * KROW, BUFSZ = B_AQ + 64 * AROW; }
NOINL void ph_gdn_prep() {
    using namespace K; using namespace gd;
    const int tid = otid(), hb = tid >> 8, t = tid & 255, lane = tid & 63, wv = t >> 6, fr = lane & 15, fq = lane >> 4;
    LAS unsigned char* base = (LAS unsigned char*)(dyn_lds + 1024 + hb * 57344);
    LAS float* Ls = (LAS float*)base;
    LAS bf16_t* Tm = (LAS bf16_t*)base;
    LAS float* gam = (LAS float*)(base + 16384);
    LAS float* bet = gam + 64;
    LAS bf16_t* BT = (LAS bf16_t*)(base + 16896);
    LAS float* egd = (LAS float*)(base + 53760);
    LAS float* beg = egd + 64;
    const bf16_t* QKb = uni(PRM.QKb); const float* GB = uni(PRM.GB);
    float* UT = uni(PRM.G_UT); bf16_t* WT = uni(PRM.G_WT); bf16_t* QG = uni(PRM.G_QG); bf16_t* KDT = uni(PRM.G_KDT); bf16_t* AQK = uni(PRM.G_AQK); float* EGL = uni(PRM.G_EGL);
    const int nit = (NCH + ogrid() * 2 - 1) / (ogrid() * 2);
    float gpre = 0.f, bpre = 0.f;
    {   const int cu0 = obid() * 2 + hb; if (cu0 < NCH && t < 64) { const int bh0 = cu0 >> 5, r00 = (bh0 >> 3) * SEQ + (cu0 & 31) * 64; gpre = GB[(size_t)(r00 + t) * 16 + (bh0 & 7)]; bpre = GB[(size_t)(r00 + t) * 16 + 8 + (bh0 & 7)]; } }
    for (int itr = 0; itr < nit; ++itr) {
        const int cu = (itr * ogrid() + obid()) * 2 + hb; const bool on = cu < NCH;
        const int bh = cu >> 5, c = cu & 31, b = bh >> 3, h = bh & 7, row0 = b * SEQ + c * 64;
        lds_barrier();
        if (on && t < 64) {
            float g = gpre;
#pragma unroll
            for (int o = 1; o < 64; o <<= 1) { const float v = __int_as_float(__builtin_amdgcn_ds_bpermute(((lane - o) & 63) << 2, __float_as_int(g))); if (lane >= o) g += v; }
            gam[t] = g; bet[t] = bpre;
            { const float gl = __int_as_float(__builtin_amdgcn_readlane(__float_as_int(g), 63)); egd[t] = __expf(gl - g); beg[t] = bpre * __expf(g); }
        }
        {   const int cun = ((itr + 1) * ogrid() + obid()) * 2 + hb;
            if (itr + 1 < nit && cun < NCH && t < 64) { const int bhn = cun >> 5, rown = (bhn >> 3) * SEQ + (cun & 31) * 64; gpre = GB[(size_t)(rown + t) * 16 + (bhn & 7)]; bpre = GB[(size_t)(rown + t) * 16 + 8 + (bhn & 7)]; } }
        lds_barrier();
        if (on) {
            const bf16_t* qb = QKb + (size_t)row0 * GC + h * 128; const bf16_t* kb = qb + GKW;
            f32x4 G[4], A[4];
#pragma unroll
            for (int nb = 0; nb < 4; ++nb) { G[nb] = (f32x4){0.f, 0.f, 0.f, 0.f}; A[nb] = (f32x4){0.f, 0.f, 0.f, 0.f}; }
            {   pg8::bf16x8 kaf[4], qaf[4], kkf[4][4];
#pragma unroll
                for (int ks = 0; ks < 4; ++ks) { kaf[ks] = *(const pg8::bf16x8*)(kb + (size_t)(16 * wv + fr) * GC + 32 * ks + 8 * fq); qaf[ks] = *(const pg8::bf16x8*)(qb + (size_t)(16 * wv + fr) * GC + 32 * ks + 8 * fq);
#pragma unroll
                    for (int nb = 0; nb < 4; ++nb) kkf[ks][nb] = *(const pg8::bf16x8*)(kb + (size_t)(16 * nb + fr) * GC + 32 * ks + 8 * fq); }
                __builtin_amdgcn_sched_barrier(0);
#pragma unroll
                for (int ks = 0; ks < 4; ++ks)
#pragma unroll
                    for (int nb = 0; nb < 4; ++nb) { G[nb] = __builtin_amdgcn_mfma_f32_16x16x32_bf16(kaf[ks], kkf[ks][nb], G[nb], 0, 0, 0); A[nb] = __builtin_amdgcn_mfma_f32_16x16x32_bf16(qaf[ks], kkf[ks][nb], A[nb], 0, 0, 0); }
                {
                    const float e = __expf(gam[16 * wv + fr]); bf16_t* dst = QG + (size_t)cu * WT_SZ + (16 * wv + fr) * 128 + 8 * fq;
#pragma unroll
                    for (int ks = 0; ks < 4; ++ks) { const u32x4 q4 = *(const u32x4*)&qaf[ks]; u32x4 o;
                        o.x = cvt_pk_bf16(__uint_as_float(q4.x << 16) * e, __uint_as_float(q4.x & 0xffff0000u) * e); o.y = cvt_pk_bf16(__uint_as_float(q4.y << 16) * e, __uint_as_float(q4.y & 0xffff0000u) * e);
                        o.z = cvt_pk_bf16(__uint_as_float(q4.z << 16) * e, __uint_as_float(q4.z & 0xffff0000u) * e); o.w = cvt_pk_bf16(__uint_as_float(q4.w << 16) * e, __uint_as_float(q4.w & 0xffff0000u) * e);
                        *(u32x4*)(dst + 32 * ks) = o; }
                }
            }
            bf16_t* aq = AQK + (size_t)cu * AQ_SZ;
#pragma unroll
            for (int nb = 0; nb < 4; ++nb) { const int j = 16 * nb + fr; const float gj = gam[j];
#pragma unroll
                for (int r = 0; r < 4; ++r) { const int i = 16 * wv + 4 * fq + r; const float dec = __expf(j <= i ? gam[i] - gj : 0.f);
                    Ls[i * 64 + j] = j < i ? bet[i] * G[nb][r] * dec : 0.f;
                    aq[i * 64 + j] = f2bf(j <= i ? A[nb][r] * dec : 0.f); } }
        }
        lds_barrier();
        if (on) {
            { float X[64];
              const bf16_t* src = QKb + (size_t)row0 * GC + (t < 128 ? 2 * GKW + h * 128 + t : GKW + h * 128 + (t - 128));
#pragma unroll
              for (int i = 0; i < 64; ++i) X[i] = __uint_as_float((unsigned)src[(size_t)i * GC] << 16);
              __builtin_amdgcn_sched_barrier(0);
              if (t >= 128) {
                  bf16_t* dst = KDT + (size_t)cu * KDT_SZ + (t - 128) * 64;
#pragma unroll
                  for (int i = 0; i < 64; i += 8) { const f32x4 e0 = *(const LAS f32x4*)(egd + i), e1 = *(const LAS f32x4*)(egd + i + 4); u32x4 o; o.x = cvt_pk_bf16(X[i] * e0[0], X[i + 1] * e0[1]); o.y = cvt_pk_bf16(X[i + 2] * e0[2], X[i + 3] * e0[3]);
                      o.z = cvt_pk_bf16(X[i + 4] * e1[0], X[i + 5] * e1[1]); o.w = cvt_pk_bf16(X[i + 6] * e1[2], X[i + 7] * e1[3]); *(u32x4*)(dst + i) = o; }
              }
#pragma unroll
              for (int i = 0; i < 64; ++i) X[i] *= t < 128 ? bet[i] : beg[i];
#pragma unroll
              for (int i = 0; i < 64; i += 8) { u32x4 w; w.x = cvt_pk_bf16(X[i], X[i + 1]); w.y = cvt_pk_bf16(X[i + 2], X[i + 3]); w.z = cvt_pk_bf16(X[i + 4], X[i + 5]); w.w = cvt_pk_bf16(X[i + 6], X[i + 7]); *(LAS u32x4*)(BT + t * 72 + i) = w; } }
            if (wv == hb) {
                float X[64]; int ln = lane; asm volatile("" : "+v"(ln));
#pragma unroll
                for (int i = 0; i < 64; ++i) X[i] = (i == ln) ? 1.f : 0.f;
#pragma unroll
                for (int i = 1; i < 41; ++i) {
                    f32x4 Lr[10]; float a0 = X[i], a1 = 0.f;
#pragma unroll
                    for (int j4 = 0; j4 < (i + 3) / 4; ++j4) Lr[j4] = *(const LAS f32x4*)(Ls + i * 64 + 4 * j4);
                    __builtin_amdgcn_sched_barrier(0);
#pragma unroll
                    for (int j4 = 0; j4 < (i + 3) / 4; ++j4) { const f32x4 L4 = Lr[j4];
                            if (j4 & 1) { a1 = fmaf(-L4[0], X[4 * j4], a1); if (4 * j4 + 1 < i) a1 = fmaf(-L4[1], X[4 * j4 + 1], a1); if (4 * j4 + 2 < i) a1 = fmaf(-L4[2], X[4 * j4 + 2], a1); if (4 * j4 + 3 < i) a1 = fmaf(-L4[3], X[4 * j4 + 3], a1); }
                            else { a0 = fmaf(-L4[0], X[4 * j4], a0); if (4 * j4 + 1 < i) a0 = fmaf(-L4[1], X[4 * j4 + 1], a0); if (4 * j4 + 2 < i) a0 = fmaf(-L4[2], X[4 * j4 + 2], a0); if (4 * j4 + 3 < i) a0 = fmaf(-L4[3], X[4 * j4 + 3], a0); } }
                    X[i] = a0 + a1;
                    __builtin_amdgcn_sched_barrier(0);
                }
#pragma unroll
                for (int i = 41; i < 64; ++i) {
                    f32x4 Lr[10], Lq[6]; float a0 = X[i], a1 = 0.f;
#pragma unroll
                    for (int j4 = 0; j4 < 10; ++j4) Lr[j4] = *(const LAS f32x4*)(Ls + i * 64 + 4 * j4);
                    __builtin_amdgcn_sched_barrier(0);
#pragma unroll
                    for (int j4 = 0; j4 < 10; ++j4) { const f32x4 L4 = Lr[j4];
                            if (j4 & 1) { a1 = fmaf(-L4[0], X[4 * j4], a1); if (4 * j4 + 1 < i) a1 = fmaf(-L4[1], X[4 * j4 + 1], a1); if (4 * j4 + 2 < i) a1 = fmaf(-L4[2], X[4 * j4 + 2], a1); if (4 * j4 + 3 < i) a1 = fmaf(-L4[3], X[4 * j4 + 3], a1); }
                            else { a0 = fmaf(-L4[0], X[4 * j4], a0); if (4 * j4 + 1 < i) a0 = fmaf(-L4[1], X[4 * j4 + 1], a0); if (4 * j4 + 2 < i) a0 = fmaf(-L4[2], X[4 * j4 + 2], a0); if (4 * j4 + 3 < i) a0 = fmaf(-L4[3], X[4 * j4 + 3], a0); } }
#pragma unroll
                    for (int j4 = 10; j4 < (i + 3) / 4; ++j4) Lq[j4 - 10] = *(const LAS f32x4*)(Ls + i * 64 + 4 * j4);
                    __builtin_amdgcn_sched_barrier(0);
#pragma unroll
                    for (int j4 = 10; j4 < (i + 3) / 4; ++j4) { const f32x4 L4 = Lq[j4 - 10];
                            if (j4 & 1) { a1 = fmaf(-L4[0], X[4 * j4], a1); if (4 * j4 + 1 < i) a1 = fmaf(-L4[1], X[4 * j4 + 1], a1); if (4 * j4 + 2 < i) a1 = fmaf(-L4[2], X[4 * j4 + 2], a1); if (4 * j4 + 3 < i) a1 = fmaf(-L4[3], X[4 * j4 + 3], a1); }
                            else { a0 = fmaf(-L4[0], X[4 * j4], a0); if (4 * j4 + 1 < i) a0 = fmaf(-L4[1], X[4 * j4 + 1], a0); if (4 * j4 + 2 < i) a0 = fmaf(-L4[2], X[4 * j4 + 2], a0); if (4 * j4 + 3 < i) a0 = fmaf(-L4[3], X[4 * j4 + 3], a0); } }
                    X[i] = a0 + a1;
                    __builtin_amdgcn_sched_barrier(0);
                }
                asm volatile("s_waitcnt lgkmcnt(0)" ::: "memory");
#pragma unroll
                for (int i = 0; i < 64; ++i) Tm[i * 72 + ln] = f2bf(X[i]);
            }
        }
        lds_barrier();
        if (on) {
            pg8::bf16x8 tf[4][2];
#pragma unroll
            for (int tb = 0; tb < 4; ++tb)
#pragma unroll
                for (int ks = 0; ks < 2; ++ks) tf[tb][ks] = *(const LAS pg8::bf16x8*)(Tm + (16 * tb + fr) * 72 + 32 * ks + 8 * fq);
#pragma unroll
            for (int cb4 = 0; cb4 < 4; ++cb4) {
                const int colb = 64 * wv + 16 * cb4;
                const pg8::bf16x8 b0 = *(const LAS pg8::bf16x8*)(BT + (colb + fr) * 72 + 8 * fq), b1 = *(const LAS pg8::bf16x8*)(BT + (colb + fr) * 72 + 32 + 8 * fq);
#pragma unroll
                for (int tb = 0; tb < 4; ++tb) {
                    f32x4 d = {0.f, 0.f, 0.f, 0.f};
                    d = __builtin_amdgcn_mfma_f32_16x16x32_bf16(b0, tf[tb][0], d, 0, 0, 0); d = __builtin_amdgcn_mfma_f32_16x16x32_bf16(b1, tf[tb][1], d, 0, 0, 0);
                    if (colb < 128) { float* up = UT + (size_t)cu * UT_SZ + (size_t)(colb + 4 * fq) * 64 + 16 * tb + fr;
#pragma unroll
                        for (int r = 0; r < 4; ++r) up[r * 64] = d[r]; }
                    else { u32x2 w; w.x = cvt_pk_bf16(d[0], d[1]); w.y = cvt_pk_bf16(d[2], d[3]); *(u32x2*)(WT + (size_t)cu * WT_SZ + (size_t)(16 * tb + fr) * 128 + (colb - 128) + 4 * fq) = w; }
                }
            }
            if (t == 0) EGL[cu] = __expf(gam[63]);
        }
    }
    __syncthreads();
}
NOINL void ph_gdn_seq(int layer, int u0, int ust) {
    using namespace K; using namespace gd;
    const int tid = otid(), lane = tid & 63, w = tid >> 6, fr = lane & 15, fq = lane >> 4;
    LAS unsigned char* lds = (LAS unsigned char*)(dyn_lds + 1024);
    const float* UT = uni(PRM.G_UT); const bf16_t* WT = uni(PRM.G_WT); const bf16_t* QG = uni(PRM.G_QG); const bf16_t* KDT = uni(PRM.G_KDT); const bf16_t* AQK = uni(PRM.G_AQK); const float* EGL = uni(PRM.G_EGL);
    float* OG = uni(PRM.OG); float* out = uni(PRM.out);
    for (int bh = u0; bh < BP * GH; bh += ust) {
        const int b = bh >> 3, h = bh & 7;
        f32x4 S[8];
#pragma unroll
        for (int mb = 0; mb < 8; ++mb) S[mb] = (f32x4){0.f, 0.f, 0.f, 0.f};
        u32x4 st[7];
        auto gload = [&](int cu) {
#pragma unroll
            for (int k = 0; k < 7; ++k) { const int pc = tid + 512 * k;
                const bf16_t* src = pc < 1024 ? WT + (size_t)cu * WT_SZ + pc * 8 : pc < 2048 ? QG + (size_t)cu * WT_SZ + (pc - 1024) * 8 : pc < 3072 ? KDT + (size_t)cu * KDT_SZ + (pc - 2048) * 8 : AQK + (size_t)cu * AQ_SZ + (pc - 3072) * 8;
                st[k] = *(const u32x4*)src; } };
        auto lstore = [&](int buf) {
#pragma unroll
            for (int k = 0; k < 7; ++k) { const int pc = tid + 512 * k; int off;
                if (pc < 1024) off = B_WT + (pc >> 4) * WROW + (pc & 15) * 16; else if (pc < 2048) off = B_QG + ((pc - 1024) >> 4) * WROW + (pc & 15) * 16;
                else if (pc < 3072) off = B_KD + ((pc - 2048) >> 3) * KROW + (pc & 7) * 16; else off = B_AQ + ((pc - 3072) >> 3) * AROW + (pc & 7) * 16;
                *(LAS u32x4*)(lds + buf * BUFSZ + off) = st[k]; } };
        const int cu0 = bh * 32;
        gload(cu0);
        __syncthreads();
        lstore(0);
        f32x4 ut[4];
#pragma unroll
        for (int tb = 0; tb < 4; ++tb) ut[tb] = *(const f32x4*)(UT + (size_t)cu0 * UT_SZ + (16 * w + fr) * 64 + 16 * tb + 4 * fq);
        float egl = EGL[cu0];
        __syncthreads();
        for (int c = 0; c < 32; ++c) {
            const int cu = cu0 + c, bo = (c & 1) * BUFSZ; const bool more = c + 1 < 32;
            if (more) gload(cu + 1);
            pg8::bf16x8 Sb[4];
#pragma unroll
            for (int ks = 0; ks < 4; ++ks) { u32x4 x; x.x = cvt_pk_bf16(S[2 * ks][0], S[2 * ks][1]); x.y = cvt_pk_bf16(S[2 * ks][2], S[2 * ks][3]); x.z = cvt_pk_bf16(S[2 * ks + 1][0], S[2 * ks + 1][1]); x.w = cvt_pk_bf16(S[2 * ks + 1][2], S[2 * ks + 1][3]); Sb[ks] = *(pg8::bf16x8*)&x; }
            f32x4 Uc[4], Oc[4];
#pragma unroll
            for (int tb = 0; tb < 4; ++tb) {
                u32x2 wf[4][2], qf2[4][2];
#pragma unroll
                for (int ks = 0; ks < 4; ++ks) {
                    const LAS unsigned char* wp = lds + bo + B_WT + (16 * tb + fr) * WROW + (32 * ks + 4 * fq) * 2; const LAS unsigned char* qp = lds + bo + B_QG + (16 * tb + fr) * WROW + (32 * ks + 4 * fq) * 2;
                    wf[ks][0] = *(const LAS u32x2*)wp; wf[ks][1] = *(const LAS u32x2*)(wp + 32); qf2[ks][0] = *(const LAS u32x2*)qp; qf2[ks][1] = *(const LAS u32x2*)(qp + 32); }
                __builtin_amdgcn_sched_barrier(0);
                f32x4 p = {0.f, 0.f, 0.f, 0.f}, o = {0.f, 0.f, 0.f, 0.f};
#pragma unroll
                for (int ks = 0; ks < 4; ++ks) {
                    u32x4 wa = {wf[ks][0].x, wf[ks][0].y, wf[ks][1].x, wf[ks][1].y}, qa = {qf2[ks][0].x, qf2[ks][0].y, qf2[ks][1].x, qf2[ks][1].y};
                    p = __builtin_amdgcn_mfma_f32_16x16x32_bf16(*(pg8::bf16x8*)&wa, Sb[ks], p, 0, 0, 0);
                    o = __builtin_amdgcn_mfma_f32_16x16x32_bf16(*(pg8::bf16x8*)&qa, Sb[ks], o, 0, 0, 0);
                }
                Uc[tb] = ut[tb] - p; Oc[tb] = o;
                __builtin_amdgcn_sched_barrier(0);
            }
            if (more) {
#pragma unroll
                for (int tb = 0; tb < 4; ++tb) ut[tb] = *(const f32x4*)(UT + (size_t)(cu + 1) * UT_SZ + (16 * w + fr) * 64 + 16 * tb + 4 * fq);
            }
            pg8::bf16x8 Ub[2];
#pragma unroll
            for (int s2 = 0; s2 < 2; ++s2) { u32x4 x; x.x = cvt_pk_bf16(Uc[2 * s2][0], Uc[2 * s2][1]); x.y = cvt_pk_bf16(Uc[2 * s2][2], Uc[2 * s2][3]); x.z = cvt_pk_bf16(Uc[2 * s2 + 1][0], Uc[2 * s2 + 1][1]); x.w = cvt_pk_bf16(Uc[2 * s2 + 1][2], Uc[2 * s2 + 1][3]); Ub[s2] = *(pg8::bf16x8*)&x; }
            u32x2 af[4][2][2];
#pragma unroll
            for (int tb = 0; tb < 4; ++tb)
#pragma unroll
                for (int s2 = 0; s2 < 2; ++s2) { const LAS unsigned char* ap = lds + bo + B_AQ + (16 * tb + fr) * AROW + (32 * s2 + 4 * fq) * 2; af[tb][s2][0] = *(const LAS u32x2*)ap; af[tb][s2][1] = *(const LAS u32x2*)(ap + 32); }
            __builtin_amdgcn_sched_barrier(0);
#pragma unroll
            for (int tb = 0; tb < 4; ++tb) {
#pragma unroll
                for (int s2 = 0; s2 < 2; ++s2) { u32x4 aa = {af[tb][s2][0].x, af[tb][s2][0].y, af[tb][s2][1].x, af[tb][s2][1].y};
                    Oc[tb] = __builtin_amdgcn_mfma_f32_16x16x32_bf16(*(pg8::bf16x8*)&aa, Ub[s2], Oc[tb], 0, 0, 0); }
                bf16_t* op = (bf16_t*)OG + (size_t)(b * SEQ + c * 64 + 16 * tb + 4 * fq) * GVW + h * 128 + 16 * w + fr;
#pragma unroll
                for (int r = 0; r < 4; ++r) op[(size_t)r * GVW] = f2bf(Oc[tb][r]);
            }
#pragma unroll
            for (int mh = 0; mh < 2; ++mh) {
                u32x2 kf[4][2][2];
#pragma unroll
                for (int m4 = 0; m4 < 4; ++m4)
#pragma unroll
                    for (int s2 = 0; s2 < 2; ++s2) { const LAS unsigned char* kp = lds + bo + B_KD + (16 * (4 * mh + m4) + fr) * KROW + (32 * s2 + 4 * fq) * 2; kf[m4][s2][0] = *(const LAS u32x2*)kp; kf[m4][s2][1] = *(const LAS u32x2*)(kp + 32); }
                __builtin_amdgcn_sched_barrier(0);
#pragma unroll
                for (int m4 = 0; m4 < 4; ++m4) { const int mb = 4 * mh + m4;
                    f32x4 sacc = S[mb] * egl;
#pragma unroll
                    for (int s2 = 0; s2 < 2; ++s2) { u32x4 ka = {kf[m4][s2][0].x, kf[m4][s2][0].y, kf[m4][s2][1].x, kf[m4][s2][1].y};
                        sacc = __builtin_amdgcn_mfma_f32_16x16x32_bf16(*(pg8::bf16x8*)&ka, Ub[s2], sacc, 0, 0, 0); }
                    S[mb] = sacc; }
                __builtin_amdgcn_sched_barrier(0);
            }
            if (more) { lstore((c + 1) & 1); egl = EGL[cu + 1]; }
            __syncthreads();
        }
        float* so = out + O_GSP + ((size_t)(layer * BP + b) * GH + h) * GDK * GDV + 16 * w + fr;
#pragma unroll
        for (int mb = 0; mb < 8; ++mb)
#pragma unroll
            for (int r = 0; r < 4; ++r) so[(size_t)(16 * mb + 4 * fq + r) * GDV] = S[mb][r];
    }
    __syncthreads();
}

#define GIDS const int tid = otid(), lane = tid & 63, wid = tid >> 6, bid_ = obid(), grid_ = ogrid(); (void)lane; (void)wid; \
    const size_t gtid = (size_t)bid_ * 512 + tid, gthreads = (size_t)grid_ * 512; (void)gtid; (void)gthreads; \
    const int gwave = bid_ * 8 + wid, gwaves = grid_ * 8; (void)gwave; (void)gwaves;

NOINL void ph_init() {
    using namespace K; GIDS
    const float* cp = uni(PRM.c_prompt); const float* cs = uni(PRM.c_sample); float* csilu = uni(PRM.csilu);
    for (size_t i = gtid; i < (size_t)NC * D; i += gthreads) {
        const int cb = (int)(i / D), k = (int)(i % D);
        const float c = cb < BP ? cp[(size_t)cb * D + k] : cs[(size_t)(cb - BP) * D + k];
        csilu[i] = silu_f(c);
    }
    { float* SPL = uni(PRM.SPL); const float* lam = uni(PRM.rg_lambda); for (size_t i = gtid; i < (size_t)DEPTH * DRNN; i += gthreads) SPL[i] = -8.0f * softplus_f(-lam[i]); }
    float* ROT = uni(PRM.ROT);
    for (size_t i = gtid; i < (size_t)(SEQ + 1) * 16; i += gthreads) {
        const int ps = (int)(i >> 4), ii = (int)(i & 15);
        const float ang = (ps < SEQ ? (float)ps : (float)PAST) * rope_inv(ii);
        ROT[2 * i] = (float)cos((double)ang); ROT[2 * i + 1] = (float)sin((double)ang);
    }
}
NOINL void ph_mod_all() {
    using namespace K;
    const int tid = otid(), cn = tid & 63, ks = tid >> 6;
    LAS float* csl = (LAS float*)(dyn_lds + 1024);
    const float* cs = uni(PRM.csilu);
    for (int u = obid(); u < DEPTH * 96; u += ogrid()) {
        const int l = u / 96, n0 = (u % 96) * 64, n = n0 + cn;
        const float* W = uni(PRM.w_ada) + (size_t)l * D * 6 * D; const float* bl = uni(PRM.b_ada) + (size_t)l * 6 * D; float* modl = uni(PRM.mod) + (size_t)l * NC * 6 * D;
        float acc[NC];
#pragma unroll
        for (int c = 0; c < NC; ++c) acc[c] = 0.f;
        for (int half = 0; half < 2; ++half) {
            __syncthreads();
            for (int i = tid; i < NC * 512; i += 512) { const int c = i >> 9, j = i & 511; csl[i] = cs[c * D + half * 512 + j]; }
            __syncthreads();
            const float* wp = W + (size_t)(half * 512 + ks * 64) * 6 * D + n;
#pragma unroll 8
            for (int kk = 0; kk < 64; kk += 4) {
                const float w0 = wp[(size_t)kk * 6 * D], w1 = wp[(size_t)(kk + 1) * 6 * D], w2 = wp[(size_t)(kk + 2) * 6 * D], w3 = wp[(size_t)(kk + 3) * 6 * D];
#pragma unroll
                for (int c = 0; c < NC; ++c) { const f32x4 c4 = *(const LAS f32x4*)(csl + c * 512 + ks * 64 + kk);
                    acc[c] = fmaf(c4[0], w0, acc[c]); acc[c] = fmaf(c4[1], w1, acc[c]); acc[c] = fmaf(c4[2], w2, acc[c]); acc[c] = fmaf(c4[3], w3, acc[c]); }
            }
        }
        __syncthreads();
#pragma unroll
        for (int c = 0; c < NC; ++c) csl[(ks * NC + c) * 64 + cn] = acc[c];
        __syncthreads();
        for (int i = tid; i < NC * 64; i += 512) { const int c = i >> 6, j = i & 63; float t = bl[n0 + j];
#pragma unroll
            for (int k2 = 0; k2 < 8; ++k2) t += csl[(k2 * NC + c) * 64 + j];
            modl[(size_t)c * 6 * D + n0 + j] = t; }
    }
    __syncthreads();
}
NOINL void ph_norm(int l, int which) {
    using namespace K; GIDS
    const bool inp = which == 0 && l == 0;
    const float* x = which == 0 ? (l == 0 ? uni(PRM.x_prompt) : uni(PRM.X2)) : uni(PRM.X1); const float* xsm = inp ? uni(PRM.x_sample) - (size_t)NP * D : x; const float* g = (which == 0 ? uni(PRM.g_norm1) : uni(PRM.g_norm2)) + (size_t)l * D; const float* modl = uni(PRM.mod) + (size_t)l * NC * 6 * D;
    bf16_t* HA = uni(PRM.HA);
    float4 gv[4];
#pragma unroll
    for (int i = 0; i < 4; ++i) gv[i] = *(const float4*)(g + i * 256 + lane * 4);
    float4 xn[2][4];
    auto ldx = [&](int rowA) {
#pragma unroll
        for (int k = 0; k < 2; ++k) { const int row = rowA + k * gwaves < R ? rowA + k * gwaves : rowA;
            if (inp) { const float* xr = (row < NP ? x : xsm) + (size_t)row * D;
#pragma unroll
                for (int i = 0; i < 4; ++i) xn[k][i] = *(const float4*)(xr + i * 256 + lane * 4); }
            else { const bf16_t* xr = (const bf16_t*)x + (size_t)row * D;
#pragma unroll
                for (int i = 0; i < 4; ++i) { const u32x2 w = *(const u32x2*)(xr + i * 256 + lane * 4); xn[k][i] = make_float4(__uint_as_float(w.x), __uint_as_float(w.y), 0.f, 0.f); } } } };
    auto xval = [&](float4 t) { if (!inp) { const unsigned a = __float_as_uint(t.x), b = __float_as_uint(t.y); t = make_float4(__uint_as_float(a << 16), __uint_as_float(a & 0xffff0000u), __uint_as_float(b << 16), __uint_as_float(b & 0xffff0000u)); } return t; };
    if (gwave < R) ldx(gwave);
    for (int rowA = gwave; rowA < R; rowA += 2 * gwaves) {
        float4 xv[2][4], scv[2][4], shv[2][4];
#pragma unroll
        for (int k = 0; k < 2; ++k) { const int row = rowA + k * gwaves < R ? rowA + k * gwaves : rowA; const float* md = modl + (size_t)cond_of_row(row) * 6 * D + which * 3 * D;
#pragma unroll
            for (int i = 0; i < 4; ++i) { const int c = i * 256 + lane * 4; xv[k][i] = xn[k][i]; scv[k][i] = *(const float4*)(md + D + c); shv[k][i] = *(const float4*)(md + c); } }
        if (rowA + 2 * gwaves < R) ldx(rowA + 2 * gwaves);
        __builtin_amdgcn_sched_barrier(0);
#pragma unroll
        for (int k = 0; k < 2; ++k) { const int row = rowA + k * gwaves; if (row < R) {
            float ss = 0.f;
#pragma unroll
            for (int i = 0; i < 4; ++i) { const float4 t = xval(xv[k][i]); ss += t.x * t.x + t.y * t.y + t.z * t.z + t.w * t.w; }
            ss = wave_sum(ss, lane); const float rs = rsqrtf(ss * (1.0f / D) + EPS);
#pragma unroll
            for (int i = 0; i < 4; ++i) { const float4 t = xval(xv[k][i]);
                const float o0 = t.x * rs * gv[i].x * (1.0f + scv[k][i].x) + shv[k][i].x, o1 = t.y * rs * gv[i].y * (1.0f + scv[k][i].y) + shv[k][i].y;
                const float o2 = t.z * rs * gv[i].z * (1.0f + scv[k][i].z) + shv[k][i].z, o3 = t.w * rs * gv[i].w * (1.0f + scv[k][i].w) + shv[k][i].w;
                u32x2 w; w.x = cvt_pk_bf16(o0, o1); w.y = cvt_pk_bf16(o2, o3); *(u32x2*)(HA + (size_t)row * D + i * 256 + lane * 4) = w; } } }
    }
}
NOINL void ph_gemm_u(int l) {
    using namespace K;
    const EpiU E{uni(PRM.URX), uni(PRM.GY), uni(PRM.UQKV), uni(PRM.SZ), uni(PRM.R1), uni(PRM.R2), uni(PRM.R3), uni(PRM.USM)}; const bf16_t* W = uni(PRM.WIN) + (size_t)l * WIN_SZ; const bf16_t* A = uni(PRM.HA);
    pg8::StaticOrder S; S.init(NP, NINP, ogrid(), obid());
    pg8::gemm_phase(GEMM_LDS, A, D, W, D, S, E);
    pg8::gemm_skinny<8>(A + (size_t)NP * D, D, W, NINP, D, NP, 64, E, 192);
}
DEVI float bf2f(bf16_t v) { return __uint_as_float((unsigned)v << 16); }
NOINL void ph_rg_state_copies(int l) {
    using namespace K; GIDS
    const bf16_t* URX = uni(PRM.URX); float* out = uni(PRM.out); const float* strg = uni(PRM.state_rg_conv);
    for (size_t i = gtid; i < (size_t)BP * 3 * DRNN; i += gthreads) { const int c = (int)(i % DRNN), j = (int)((i / DRNN) % 3), b = (int)(i / (3 * DRNN));
        out[O_RGCP + (size_t)l * BP * 3 * DRNN + i] = bf2f(URX[(size_t)(b * SEQ + SEQ - 3 + j) * DRNN + c]); }
    for (size_t i = gtid; i < (size_t)BS * 3 * DRNN; i += gthreads) { const int c = (int)(i % DRNN), j = (int)((i / DRNN) % 3), sb = (int)(i / (3 * DRNN));
        out[O_RGCS + (size_t)l * BS * 3 * DRNN + i] = j < 2 ? strg[((size_t)(l * BS + sb) * 3 + j + 1) * DRNN + c] : bf2f(URX[(size_t)(NP + sb) * DRNN + c]); }
}
NOINL void ph_rg_sample(int l, int vb, int vgrid) {
    using namespace K;
    const int tid = otid(), bid_ = vb, grid_ = vgrid; const size_t gtid = (size_t)bid_ * 512 + tid, gthreads = (size_t)grid_ * 512;
    const bf16_t* URX = uni(PRM.URX); const bf16_t* GY = uni(PRM.GY); float* XC = uni(PRM.XC); float* out = uni(PRM.out); const float* strg = uni(PRM.state_rg_conv); bf16_t* CAT = uni(PRM.CAT);
    const float* cw = uni(PRM.rg_conv_w) + (size_t)l * 4 * DRNN; const float* cbias = uni(PRM.rg_conv_b) + (size_t)l * DRNN;
    const float* wa = uni(PRM.rg_wa) + (size_t)l * RGN * RGB * RGB; const float* wx = uni(PRM.rg_wx) + (size_t)l * RGN * RGB * RGB;
    const float* ba = uni(PRM.rg_ba) + (size_t)l * DRNN; const float* bx = uni(PRM.rg_bx) + (size_t)l * DRNN; const float* spl = uni(PRM.SPL) + (size_t)l * DRNN; const float* sth = uni(PRM.state_rg_h) + (size_t)l * BS * DRNN;
    LAS float* xs = (LAS float*)(dyn_lds + 1024);
    const int grp = tid >> 7, cl = tid & 127;
    for (int g0 = bid_ * 4; g0 < BS * RGN; g0 += grid_ * 4) {
        const int g = g0 + grp; const bool on = g < BS * RGN; const int sb = on ? g / RGN : 0, n = on ? g % RGN : 0, c = n * RGB + cl, row = NP + sb;
        float xc = 0.f;
        if (on) { const float* st = strg + ((size_t)(l * BS + sb) * 3) * DRNN; xc = cbias[c];
#pragma unroll
            for (int j = 0; j < 3; ++j) xc = fmaf(cw[j * DRNN + c], st[j * DRNN + c], xc);
            xc = fmaf(cw[3 * DRNN + c], bf2f(URX[(size_t)row * DRNN + c]), xc); }
        __syncthreads();
        xs[grp * 128 + cl] = xc;
        __syncthreads();
        if (on) {
            float gr = ba[c], gi = bx[c];
            const bf16_t* wr = uni(PRM.WRG) + ((size_t)l * RGN + n) * 256 * 128 + (size_t)cl * 128; const bf16_t* wi = wr + 128 * 128;
#pragma unroll
            for (int hb = 0; hb < 2; ++hb) {
                u32x4 wa8[8], wx8[8];
#pragma unroll
                for (int q = 0; q < 8; ++q) { wa8[q] = *(const u32x4*)(wr + 64 * hb + 8 * q); wx8[q] = *(const u32x4*)(wi + 64 * hb + 8 * q); }
                __builtin_amdgcn_sched_barrier(0);
#pragma unroll
                for (int q = 0; q < 8; ++q) { const f32x4 x0 = *(const LAS f32x4*)(xs + grp * 128 + 64 * hb + 8 * q), x1 = *(const LAS f32x4*)(xs + grp * 128 + 64 * hb + 8 * q + 4);
                    const u32x4 a = wa8[q], b = wx8[q];
                    gr = fmaf(x0[0], __uint_as_float(a.x << 16), gr); gr = fmaf(x0[1], __uint_as_float(a.x & 0xffff0000u), gr); gr = fmaf(x0[2], __uint_as_float(a.y << 16), gr); gr = fmaf(x0[3], __uint_as_float(a.y & 0xffff0000u), gr);
                    gr = fmaf(x1[0], __uint_as_float(a.z << 16), gr); gr = fmaf(x1[1], __uint_as_float(a.z & 0xffff0000u), gr); gr = fmaf(x1[2], __uint_as_float(a.w << 16), gr); gr = fmaf(x1[3], __uint_as_float(a.w & 0xffff0000u), gr);
                    gi = fmaf(x0[0], __uint_as_float(b.x << 16), gi); gi = fmaf(x0[1], __uint_as_float(b.x & 0xffff0000u), gi); gi = fmaf(x0[2], __uint_as_float(b.y << 16), gi); gi = fmaf(x0[3], __uint_as_float(b.y & 0xffff0000u), gi);
                    gi = fmaf(x1[0], __uint_as_float(b.z << 16), gi); gi = fmaf(x1[1], __uint_as_float(b.z & 0xffff0000u), gi); gi = fmaf(x1[2], __uint_as_float(b.w << 16), gi); gi = fmaf(x1[3], __uint_as_float(b.w & 0xffff0000u), gi); }
                __builtin_amdgcn_sched_barrier(0);
            }
            const float r = fast_sigmoid(gr), ii = fast_sigmoid(gi), la = r * spl[c], a = __expf(la), bm = sqrtf(neg_expm1_small(2.0f * la));
            const float h = a * sth[(size_t)sb * DRNN + c] + bm * (ii * xc);
            CAT[(size_t)row * CATW + CAT_RG + c] = f2bf(h * fast_gelu_tanh(bf2f(GY[(size_t)row * DRNN + c])));
            out[O_RGHS + ((size_t)l * BS + sb) * DRNN + c] = h;
        }
    }
    __syncthreads();
}
NOINL void ph_tok_gdn(int l) {
    using namespace K; GIDS
    const bf16_t* UQ = uni(PRM.UQKV); const float* USM = uni(PRM.USM); float* QKVC = uni(PRM.QKVC); float* GB = uni(PRM.GB); float* out = uni(PRM.out); const float* stg = uni(PRM.state_gdn_conv); bf16_t* QKb = uni(PRM.QKb);
    const float* cw = uni(PRM.gdn_conv_w) + (size_t)l * 4 * GC; const float* Alog = uni(PRM.gdn_A_log) + l * GH; const float* dtb = uni(PRM.gdn_dt_bias) + l * GH;
    {
        const size_t gth = (gthreads / 384) * 384, nit = gtid < gth ? (size_t)(NP / 8) * 384 : 0;
        const int cg = (int)(gtid % 384), c0 = cg * 8, slot = cg >> 4;
        float4 wv0[4], wv1[4];
#pragma unroll
        for (int j = 0; j < 4; ++j) { wv0[j] = *(const float4*)(cw + (size_t)j * GC + c0); wv1[j] = *(const float4*)(cw + (size_t)j * GC + c0 + 4); }
        u32x4 xn[11];
        if (gtid < nit) { const int row0 = (int)(gtid / 384) * 8, t0 = row0 & (SEQ - 1);
#pragma unroll
            for (int i = 0; i < 11; ++i) xn[i] = (t0 - 3 + i) >= 0 ? *(const u32x4*)(UQ + (size_t)(row0 - 3 + i) * GC + c0) : (u32x4){0u, 0u, 0u, 0u}; }
        for (size_t it = gtid; it < nit; it += gth) {
            const int row0 = (int)(it / 384) * 8;
            u32x4 xr[11];
#pragma unroll
            for (int i = 0; i < 11; ++i) xr[i] = xn[i];
            if (it + gth < nit) { const int rown = (int)((it + gth) / 384) * 8, tn = rown & (SEQ - 1);
#pragma unroll
                for (int i = 0; i < 11; ++i) xn[i] = (tn - 3 + i) >= 0 ? *(const u32x4*)(UQ + (size_t)(rown - 3 + i) * GC + c0) : (u32x4){0u, 0u, 0u, 0u}; }
            __builtin_amdgcn_sched_barrier(0);
#pragma unroll
            for (int o = 0; o < 8; ++o) {
                float a[8];
#pragma unroll
                for (int e = 0; e < 8; ++e) a[e] = 0.f;
#pragma unroll
                for (int j = 0; j < 4; ++j) { const u32x4 w = xr[o + j]; const float4 w0 = wv0[j], w1 = wv1[j];
                    a[0] = fmaf(w0.x, __uint_as_float(w.x << 16), a[0]); a[1] = fmaf(w0.y, __uint_as_float(w.x & 0xffff0000u), a[1]); a[2] = fmaf(w0.z, __uint_as_float(w.y << 16), a[2]); a[3] = fmaf(w0.w, __uint_as_float(w.y & 0xffff0000u), a[3]);
                    a[4] = fmaf(w1.x, __uint_as_float(w.z << 16), a[4]); a[5] = fmaf(w1.y, __uint_as_float(w.z & 0xffff0000u), a[5]); a[6] = fmaf(w1.z, __uint_as_float(w.w << 16), a[6]); a[7] = fmaf(w1.w, __uint_as_float(w.w & 0xffff0000u), a[7]); }
                float ss = 0.f;
#pragma unroll
                for (int e = 0; e < 8; ++e) { a[e] = a[e] * fast_sigmoid(a[e]); ss += a[e] * a[e]; }
                ss = row16_sum(ss);
                if (slot < 16) { const float sc = rsqrtf(ss + EPS) * (slot < 8 ? 0.08838834764831845f : 1.0f);
#pragma unroll
                    for (int e = 0; e < 8; ++e) a[e] *= sc; }
                u32x4 w; w.x = cvt_pk_bf16(a[0], a[1]); w.y = cvt_pk_bf16(a[2], a[3]); w.z = cvt_pk_bf16(a[4], a[5]); w.w = cvt_pk_bf16(a[6], a[7]); *(u32x4*)(QKb + (size_t)(row0 + o) * GC + c0) = w;
            }
        }
    }
    for (size_t it = gtid; it < (size_t)BS * 384; it += gthreads) {
        const int row = NP + (int)(it / 384), cg = (int)(it % 384), c0 = cg * 8, slot = cg >> 4;
        float a[8];
#pragma unroll
        for (int e = 0; e < 8; ++e) a[e] = 0.f;
        u32x4 xr[4]; float4 xs0[3], xs1[3], wv0[4], wv1[4]; bool have[4];
#pragma unroll
        for (int j = 0; j < 4; ++j) {
            have[j] = row >= NP || ((row & (SEQ - 1)) - 3 + j) >= 0;
            wv0[j] = *(const float4*)(cw + (size_t)j * GC + c0); wv1[j] = *(const float4*)(cw + (size_t)j * GC + c0 + 4);
            if (row < NP) { xr[j] = have[j] ? *(const u32x4*)(UQ + (size_t)(row - 3 + j) * GC + c0) : (u32x4){0u, 0u, 0u, 0u}; }
            else if (j < 3) { const float* st = stg + ((size_t)(l * BS + (row - NP)) * 3 + j) * GC + c0; xs0[j] = *(const float4*)st; xs1[j] = *(const float4*)(st + 4); }
            else xr[j] = *(const u32x4*)(UQ + (size_t)row * GC + c0);
        }
        __builtin_amdgcn_sched_barrier(0);
#pragma unroll
        for (int j = 0; j < 4; ++j) {
            float x[8];
            if (row >= NP && j < 3) { x[0] = xs0[j].x; x[1] = xs0[j].y; x[2] = xs0[j].z; x[3] = xs0[j].w; x[4] = xs1[j].x; x[5] = xs1[j].y; x[6] = xs1[j].z; x[7] = xs1[j].w; }
            else { const u32x4 w = xr[j];
                x[0] = __uint_as_float(w.x << 16); x[1] = __uint_as_float(w.x & 0xffff0000u); x[2] = __uint_as_float(w.y << 16); x[3] = __uint_as_float(w.y & 0xffff0000u);
                x[4] = __uint_as_float(w.z << 16); x[5] = __uint_as_float(w.z & 0xffff0000u); x[6] = __uint_as_float(w.w << 16); x[7] = __uint_as_float(w.w & 0xffff0000u); }
            if (have[j]) { const float4 w0 = wv0[j], w1 = wv1[j];
                a[0] = fmaf(w0.x, x[0], a[0]); a[1] = fmaf(w0.y, x[1], a[1]); a[2] = fmaf(w0.z, x[2], a[2]); a[3] = fmaf(w0.w, x[3], a[3]);
                a[4] = fmaf(w1.x, x[4], a[4]); a[5] = fmaf(w1.y, x[5], a[5]); a[6] = fmaf(w1.z, x[6], a[6]); a[7] = fmaf(w1.w, x[7], a[7]); }
        }
        float ss = 0.f;
#pragma unroll
        for (int e = 0; e < 8; ++e) { a[e] = a[e] * fast_sigmoid(a[e]); ss += a[e] * a[e]; }
        ss += shx(ss, 1, lane); ss += shx(ss, 2, lane); ss += shx(ss, 4, lane); ss += shx(ss, 8, lane);
        if (slot < 16) { const float sc = rsqrtf(ss + EPS) * (slot < 8 ? 0.08838834764831845f : 1.0f);
#pragma unroll
            for (int e = 0; e < 8; ++e) a[e] *= sc; }
        if (row < NP) { u32x4 w; w.x = cvt_pk_bf16(a[0], a[1]); w.y = cvt_pk_bf16(a[2], a[3]); w.z = cvt_pk_bf16(a[4], a[5]); w.w = cvt_pk_bf16(a[6], a[7]); *(u32x4*)(QKb + (size_t)row * GC + c0) = w; }
        else { float* q = QKVC + (size_t)row * GC + c0; *(float4*)q = make_float4(a[0], a[1], a[2], a[3]); *(float4*)(q + 4) = make_float4(a[4], a[5], a[6], a[7]); }
    }
    for (size_t i = gtid; i < (size_t)BP * 3 * GC; i += gthreads) { const int c = (int)(i % GC), j = (int)((i / GC) % 3), b = (int)(i / (3 * GC));
        out[O_GCP + (size_t)l * BP * 3 * GC + i] = bf2f(UQ[(size_t)(b * SEQ + SEQ - 3 + j) * GC + c]); }
    for (size_t i = gtid; i < (size_t)BS * 3 * GC; i += gthreads) { const int c = (int)(i % GC), j = (int)((i / GC) % 3), sb = (int)(i / (3 * GC));
        out[O_GCS + (size_t)l * BS * 3 * GC + i] = j < 2 ? stg[((size_t)(l * BS + sb) * 3 + j + 1) * GC + c] : bf2f(UQ[(size_t)(NP + sb) * GC + c]); }
    for (size_t i = gtid; i < (size_t)R * GH; i += gthreads) { const int row = (int)(i / GH), h = (int)(i % GH);
        GB[(size_t)row * 16 + h] = -__expf(Alog[h]) * fast_softplus(bf2f(((const bf16_t*)USM)[(size_t)row * USMW + SM_A + h]) + dtb[h]);
        GB[(size_t)row * 16 + 8 + h] = fast_sigmoid(bf2f(((const bf16_t*)USM)[(size_t)row * USMW + SM_B + h])); }
}
NOINL void ph_tok_mla(int l) {
    using namespace K; GIDS
    const float* USM = uni(PRM.USM); float* CKV = uni(PRM.CKV); float* KR = uni(PRM.KR); float* out = uni(PRM.out); const float* ROT = uni(PRM.ROT); bf16_t* AQ = uni(PRM.AQ); bf16_t* AKV = uni(PRM.AKV); bf16_t* Kb = uni(PRM.Kb);
    const float* gq = uni(PRM.mla_q_norm_g) + (size_t)l * QL; const float* gkv = uni(PRM.mla_kv_norm_g) + (size_t)l * KVL;
    for (int rowA = gwave; rowA < R; rowA += 2 * gwaves) {
        unsigned a2r[2][6], c2r[2][4], x12r[2][2];
#pragma unroll
        for (int k = 0; k < 2; ++k) { const int row = rowA + k * gwaves < R ? rowA + k * gwaves : rowA; const bf16_t* ur = (const bf16_t*)USM + (size_t)row * USMW;
#pragma unroll
            for (int i = 0; i < 6; ++i) a2r[k][i] = ur[SM_MQ + i * 64 + lane];
#pragma unroll
            for (int i = 0; i < 4; ++i) c2r[k][i] = ur[SM_MKV + i * 64 + lane];
            x12r[k][0] = ur[SM_MKV + KVL + (lane & 15)]; x12r[k][1] = ur[SM_MKV + KVL + 16 + (lane & 15)]; }
        __builtin_amdgcn_sched_barrier(0);
        float a2[2][6], c2[2][4], x12[2][2];
#pragma unroll
        for (int k = 0; k < 2; ++k) {
#pragma unroll
            for (int i = 0; i < 6; ++i) a2[k][i] = __uint_as_float(a2r[k][i] << 16);
#pragma unroll
            for (int i = 0; i < 4; ++i) c2[k][i] = __uint_as_float(c2r[k][i] << 16);
            x12[k][0] = __uint_as_float(x12r[k][0] << 16); x12[k][1] = __uint_as_float(x12r[k][1] << 16); }
#pragma unroll
        for (int k = 0; k < 2; ++k) { const int row = rowA + k * gwaves; if (row < R) {
            float ss = 0.f;
#pragma unroll
            for (int i = 0; i < 6; ++i) ss += a2[k][i] * a2[k][i];
            ss = wave_sum(ss, lane); float rs = rsqrtf(ss * (1.0f / QL) + EPS);
#pragma unroll
            for (int i = 0; i < 6; ++i) AQ[(size_t)row * QL + i * 64 + lane] = f2bf(a2[k][i] * rs * gq[i * 64 + lane]);
            ss = 0.f;
#pragma unroll
            for (int i = 0; i < 4; ++i) ss += c2[k][i] * c2[k][i];
            ss = wave_sum(ss, lane); rs = rsqrtf(ss * (1.0f / KVL) + EPS);
            float* ckvo = row < NP ? out + O_CKVP + ((size_t)l * NP + row) * KVL : out + O_CKVS + ((size_t)l * BS + (row - NP)) * KVL;
#pragma unroll
            for (int i = 0; i < 4; ++i) { const float v = c2[k][i] * rs * gkv[i * 64 + lane]; if (row >= NP) CKV[(size_t)row * KVL + i * 64 + lane] = v; ckvo[i * 64 + lane] = v; AKV[(size_t)row * KVL + i * 64 + lane] = f2bf(v); }
            if (lane < 32) {
                const int i = lane & 15; const float2 cs = *(const float2*)(ROT + (size_t)(pslot_of_row(row) * 16 + i) * 2);
                const float c = cs.x, sn = cs.y;
                const float x1 = x12[k][0], x2 = x12[k][1];
                const float v = lane < 16 ? (x1 * c - x2 * sn) : (x2 * c + x1 * sn);
                if (row >= NP) KR[(size_t)row * ROPE + lane] = v;
                if (row < NP) { const bf16_t vb = f2bf(v); bf16_t* kp = Kb + (size_t)row * 768 + 64 + 2 * i + (lane >> 4);
#pragma unroll
                    for (int hh = 0; hh < MH; ++hh) kp[hh * 96] = vb; }
                float* kro = row < NP ? out + O_KRP + ((size_t)l * NP + row) * ROPE : out + O_KRS + ((size_t)l * BS + (row - NP)) * ROPE;
                kro[lane] = v;
            } } }
    }
}
NOINL void ph_gemm_qkv(int l) {
    using namespace K;
    { const EpiQ E{uni(PRM.Qb), uni(PRM.ROT)}; const bf16_t* W = uni(PRM.WUQP) + (size_t)l * 768 * QL; const bf16_t* A = uni(PRM.AQ);
      pg8::StaticOrder S; S.init(NP, 768, ogrid(), obid());
      pg8::gemm_phase(GEMM_LDS, A, QL, W, QL, S, E); }
    { const EpiF32 E{uni(PRM.Q), 768}; pg8::gemm_skinny<4>(uni(PRM.AQ) + (size_t)NP * QL, QL, uni(PRM.WUQ) + (size_t)l * 768 * QL, 768, QL, NP, 192, E); }
    { const EpiK E{uni(PRM.Kb)}; const bf16_t* W = uni(PRM.WK) + (size_t)l * 512 * KVL; const bf16_t* A = uni(PRM.AKV);
      pg8::StaticOrder S; S.init(NP, 512, ogrid(), obid());
      pg8::gemm_phase(GEMM_LDS, A, KVL, W, KVL, S, E); }
    { const EpiBf16 E{uni(PRM.Vt), NP}; const bf16_t* A = uni(PRM.WV) + (size_t)l * 1024 * KVL; const bf16_t* Bt = uni(PRM.AKV);
      pg8::StaticOrder S; S.init(1024, NP, ogrid(), obid());
      pg8::gemm_phase(GEMM_LDS, A, KVL, Bt, KVL, S, E); }
}
NOINL void ph_rope_q() {
    using namespace K; GIDS
    float* Q = uni(PRM.Q); const float* ROT = uni(PRM.ROT);
    for (size_t i = gtid; i < (size_t)BS * MH * 16; i += gthreads) {
        const int row = NP + (int)(i / (MH * 16)), h = (int)((i / 16) % MH), ii = (int)(i % 16);
        const float2 cs = *(const float2*)(ROT + (size_t)(pslot_of_row(row) * 16 + ii) * 2);
        const float c = cs.x, sn = cs.y;
        float* qp = Q + (size_t)row * 768 + h * 96 + 64;
        const float x1 = qp[ii], x2 = qp[16 + ii];
        qp[ii] = x1 * c - x2 * sn; qp[16 + ii] = x2 * c + x1 * sn;
    }
}
NOINL void ph_rg_prompt(int l, int u0, int ust) {
    using namespace K;
    const int tid = otid(), lane = tid & 63, wid = tid >> 6, fr = lane & 15, fq = lane >> 4, bid = obid(), grid = ogrid();
    LAS unsigned char* base = (LAS unsigned char*)(dyn_lds + 1024);
    LAS bf16_t* XA = (LAS bf16_t*)base;
    LAS float* XCF = (LAS float*)(base + 17408);
    LAS float* AS = (LAS float*)(base + 34816);
    LAS float* BS_ = (LAS float*)(base + 34816 + 16640);
    LAS float* PA = (LAS float*)(base + 34816 + 2 * 16640);
    LAS float* PH = PA + 512;
    LAS float* CARRY = PH + 512;
    const bf16_t* URX = uni(PRM.URX); const bf16_t* GYp = uni(PRM.GY); bf16_t* CAT = uni(PRM.CAT); float* out = uni(PRM.out);
    const int tb = wid & 3, chh = wid >> 2;
    const int cc = tid & 127, seg = tid >> 7;
    const int chs = tid & 63, tg = tid >> 6;
    for (int unit = u0; unit < BP * RGN * 2; unit += ust) {
        const int b = unit / (RGN * 2), n = (unit % (RGN * 2)) >> 1, half = unit & 1, ch0 = n * RGB + half * 64;
        pg8::bf16x8 wfr[4][4];
        { const bf16_t* W = uni(PRM.WRG) + ((size_t)l * RGN + n) * 256 * 128;
#pragma unroll
          for (int nbk = 0; nbk < 4; ++nbk)
#pragma unroll
            for (int ks = 0; ks < 4; ++ks) wfr[nbk][ks] = *(const pg8::bf16x8*)(W + (size_t)((nbk >> 1) * 128 + half * 64 + chh * 32 + (nbk & 1) * 16 + fr) * 128 + ks * 32 + 8 * fq); }
        float cba[2][4], cbx[2][4], csp[2][4];
#pragma unroll
        for (int nb = 0; nb < 2; ++nb)
#pragma unroll
            for (int r = 0; r < 4; ++r) { const int c = ch0 + chh * 32 + nb * 16 + 4 * fq + r;
                cba[nb][r] = uni(PRM.rg_ba)[(size_t)l * DRNN + c]; cbx[nb][r] = uni(PRM.rg_bx)[(size_t)l * DRNN + c]; csp[nb][r] = uni(PRM.SPL)[(size_t)l * DRNN + c]; }
        float cw[4]; const float cbias = uni(PRM.rg_conv_b)[(size_t)l * DRNN + n * RGB + cc];
#pragma unroll
        for (int j = 0; j < 4; ++j) cw[j] = uni(PRM.rg_conv_w)[((size_t)l * 4 + j) * DRNN + n * RGB + cc];
        __syncthreads();
        if (tid < 128) CARRY[tid] = 0.f;
        const bf16_t* ux = URX + (size_t)(b * SEQ) * DRNN + n * RGB + cc;
        const bf16_t* uy = GYp + (size_t)(b * SEQ) * DRNN + ch0 + chs;
        unsigned raw[19], gy[8];
        {   int r0 = seg * 16 - 3, r1 = tg * 8;
            asm volatile("" : "+v"(r0), "+v"(r1));
#pragma unroll
            for (int i = 0; i < 19; ++i) { const int t = r0 + i; raw[i] = t >= 0 ? (unsigned)ux[(unsigned)(t < 0 ? 0 : t) * (unsigned)DRNN] : 0u; }
#pragma unroll
            for (int i = 0; i < 8; ++i) gy[i] = (unsigned)uy[(unsigned)(r1 + i) * (unsigned)DRNN]; }
        float hlast = 0.f;
        for (int tile = 0; tile < SEQ / 64; ++tile) {
#pragma unroll
            for (int j = 0; j < 16; ++j) {
                const float xc = cbias + cw[0] * __uint_as_float(raw[j] << 16) + cw[1] * __uint_as_float(raw[j + 1] << 16) + cw[2] * __uint_as_float(raw[j + 2] << 16) + cw[3] * __uint_as_float(raw[j + 3] << 16);
                XA[(seg * 16 + j) * 136 + cc] = f2bf(xc);
                if ((cc >> 6) == half) XCF[(seg * 16 + j) * 68 + (cc & 63)] = xc;
            }
            float gyc[8];
#pragma unroll
            for (int i = 0; i < 8; ++i) gyc[i] = __uint_as_float(gy[i] << 16);
            if (tile + 1 < SEQ / 64) {
                int r0 = (tile + 1) * 64 + seg * 16 - 3, r1 = (tile + 1) * 64 + tg * 8;
                asm volatile("" : "+v"(r0), "+v"(r1));
#pragma unroll
                for (int i = 0; i < 19; ++i) raw[i] = (unsigned)ux[(unsigned)(r0 + i) * (unsigned)DRNN];
#pragma unroll
                for (int i = 0; i < 8; ++i) gy[i] = (unsigned)uy[(unsigned)(r1 + i) * (unsigned)DRNN];
            }
            lds_barrier();
            f32x4 acc[4];
#pragma unroll
            for (int nbk = 0; nbk < 4; ++nbk) acc[nbk] = (f32x4){0.f, 0.f, 0.f, 0.f};
#pragma unroll
            for (int ks = 0; ks < 4; ++ks) {
                const pg8::bf16x8 xf = *(const LAS pg8::bf16x8*)(XA + (tb * 16 + fr) * 136 + ks * 32 + 8 * fq);
#pragma unroll
                for (int nbk = 0; nbk < 4; ++nbk) acc[nbk] = __builtin_amdgcn_mfma_f32_16x16x32_bf16(wfr[nbk][ks], xf, acc[nbk], 0, 0, 0);
            }
            { const int tok = tb * 16 + fr;
#pragma unroll
              for (int nb = 0; nb < 2; ++nb)
#pragma unroll
                for (int r = 0; r < 4; ++r) {
                    const int c = chh * 32 + nb * 16 + 4 * fq + r;
                    const float rg = fast_sigmoid(acc[nb][r] + cba[nb][r]), ig = fast_sigmoid(acc[2 + nb][r] + cbx[nb][r]);
                    const float la = rg * csp[nb][r];
                    const float a = __expf(la), bm = sqrtf(neg_expm1_small(2.0f * la));
                    AS[tok * 65 + c] = a; BS_[tok * 65 + c] = bm * (ig * XCF[tok * 68 + c]);
                } }
            lds_barrier();
            float av[8], bv[8]; float P = 1.f, H = 0.f;
#pragma unroll
            for (int i = 0; i < 8; ++i) { av[i] = AS[(tg * 8 + i) * 65 + chs]; bv[i] = BS_[(tg * 8 + i) * 65 + chs]; P *= av[i]; H = av[i] * H + bv[i]; }
            PA[tg * 64 + chs] = P; PH[tg * 64 + chs] = H;
            lds_barrier();
            float h = CARRY[(tile & 1) * 64 + chs];
            for (int g = 0; g < tg; ++g) h = PA[g * 64 + chs] * h + PH[g * 64 + chs];
            bf16_t* op = CAT + (size_t)(b * SEQ + tile * 64 + tg * 8) * CATW + CAT_RG + ch0 + chs;
#pragma unroll
            for (int i = 0; i < 8; ++i) { h = av[i] * h + bv[i]; op[(size_t)i * CATW] = f2bf(h * fast_gelu_tanh(gyc[i])); }
            if (tg == 7) { CARRY[((tile + 1) & 1) * 64 + chs] = h; hlast = h; }
        }
        if (tg == 7) out[O_RGHP + ((size_t)l * BP + b) * DRNN + ch0 + chs] = hlast;
    }
    __syncthreads();
}
namespace dc { constexpr int QLS = 0, PW = 9216, AL = PW + 8 * 1024, CMB = AL + 8 * 64, WSTR = 16 * 592, QB16 = CMB + 8 * WSTR + 512;
    static_assert(8 * 264 * 4 <= WSTR && QB16 + 16 * 592 <= 131072, "decode LDS map"); }
NOINL void ph_attn_sample(int l, int u0, int ust) {
    using namespace K;
    const int tid = otid(), lane = tid & 63, w = __builtin_amdgcn_readfirstlane(tid >> 6), fr = lane & 15, fq = lane >> 4;
    LAS float* ldsf = (LAS float*)(dyn_lds + 1024);
    LAS float* QLs = ldsf + dc::QLS / 4;
    LAS float* Pw = ldsf + dc::PW / 4 + w * 256;
    LAS float* ALw = ldsf + dc::AL / 4 + w * 16;
    LAS float* CMB = ldsf + dc::CMB / 4;
    const bf16_t* WKl = uni(PRM.WK) + (size_t)l * 512 * KVL; const float* ckvl = uni(PRM.cache_ckv) + (size_t)l * NPOOL * PAGE * KVL; const float* krl = uni(PRM.cache_krope) + (size_t)l * NPOOL * PAGE * ROPE;
    const float* Q = uni(PRM.Q); const int* ptab = uni(PRM.page_table); float* PART = uni(PRM.PART); float* QLG = uni(PRM.QLG); const float* ROT = uni(PRM.ROT);
    const float sc = 0.10206207261596577f * 1.4426950408889634f;
    for (int unit = u0; unit < BS * 8; unit += ust) {
        const int sb = unit >> 3, sp = unit & 7, row = NP + sb;
        __syncthreads();
        {
            const int t1 = otid(), lane = t1 & 63, w = __builtin_amdgcn_readfirstlane(t1 >> 6);
            const float* qp = Q + (size_t)row * 768 + w * 96;
            const bf16_t* wk = WKl + (size_t)(w * 64) * KVL + 4 * lane;
            float ql[4] = {0.f, 0.f, 0.f, 0.f};
#pragma unroll
            for (int hb = 0; hb < 2; ++hb) {
                u32x2 wr[32];
#pragma unroll
                for (int d = 0; d < 32; ++d) wr[d] = *(const u32x2*)(wk + (size_t)(32 * hb + d) * KVL);
                __builtin_amdgcn_sched_barrier(0);
#pragma unroll
                for (int d = 0; d < 32; ++d) { const float qv = qp[32 * hb + d];
                    ql[0] = fmaf(qv, __uint_as_float(wr[d].x << 16), ql[0]); ql[1] = fmaf(qv, __uint_as_float(wr[d].x & 0xffff0000u), ql[1]);
                    ql[2] = fmaf(qv, __uint_as_float(wr[d].y << 16), ql[2]); ql[3] = fmaf(qv, __uint_as_float(wr[d].y & 0xffff0000u), ql[3]); }
                __builtin_amdgcn_sched_barrier(0);
            }
#pragma unroll
            for (int j = 0; j < 4; ++j) QLs[w * 288 + 4 * lane + j] = ql[j] * sc;
            if (lane < 32) { const int i = lane & 15; const float2 cs = *(const float2*)(ROT + (size_t)(SEQ * 16 + i) * 2);
                const float x1 = qp[64 + i], x2 = qp[80 + i]; QLs[w * 288 + 256 + lane] = (lane < 16 ? x1 * cs.x - x2 * cs.y : x2 * cs.x + x1 * cs.y) * sc; }
        }
        __syncthreads();
        if (sp == 0) for (int i = otid(); i < 8 * 288; i += 512) QLG[(size_t)sb * 8 * 288 + i] = QLs[i];
        for (int i = otid(); i < 16 * 36; i += 512) { const int rr = i / 36, c = i - 36 * rr; u32x4 t = {0u, 0u, 0u, 0u};
            if (rr < 8) { const LAS float* p = QLs + rr * 288 + 8 * c; t.x = cvt_pk_bf16(p[0], p[1]); t.y = cvt_pk_bf16(p[2], p[3]); t.z = cvt_pk_bf16(p[4], p[5]); t.w = cvt_pk_bf16(p[6], p[7]); }
            *(LAS u32x4*)(dyn_lds + 1024 + dc::QB16 + rr * 592 + c * 16) = t; }
        __syncthreads();
        const LAS unsigned char* qfl = (const LAS unsigned char*)(dyn_lds + 1024 + dc::QB16) + fr * 592 + fq * 16;
        float mrun[4], lrun[4], acc[8][4];
#pragma unroll
        for (int r = 0; r < 4; ++r) { mrun[r] = -1e30f; lrun[r] = 0.f; }
#pragma unroll
        for (int hh = 0; hh < 8; ++hh)
#pragma unroll
            for (int j = 0; j < 4; ++j) acc[hh][j] = 0.f;
        const __amdgpu_buffer_rsrc_t rC = __builtin_amdgcn_make_buffer_rsrc((void*)ckvl, 0, 0x7ffffff0, 0x00020000), rK = __builtin_amdgcn_make_buffer_rsrc((void*)krl, 0, 0x7ffffff0, 0x00020000);
        const int voP = lane * 16;
        LAS unsigned char* tw = (LAS unsigned char*)(dyn_lds + 1024 + dc::CMB) + w * dc::WSTR;
        const LAS unsigned char* tfr = tw + fr * 592 + fq * 16;
        LAS unsigned char* twv = tw + lane * 8;
        LAS unsigned char* twk = tw + (lane >> 3) * 592 + 512 + (lane & 7) * 8;
        const int pg0 = __builtin_amdgcn_readfirstlane(ptab[sb * NPAGES + sp * 16 + 2 * w]), pg1 = __builtin_amdgcn_readfirstlane(ptab[sb * NPAGES + sp * 16 + 2 * w + 1]);
        u32x4 V[16], KRr[2];
        {   const int rowb = pg0 * PAGE;
#pragma unroll
            for (int j = 0; j < 2; ++j) KRr[j] = __builtin_amdgcn_raw_buffer_load_b128(rK, voP, (rowb + 8 * j) * ROPE * 4, 0);
#pragma unroll
            for (int q = 0; q < 16; ++q) V[q] = __builtin_amdgcn_raw_buffer_load_b128(rC, voP, (rowb + q) * KVL * 4, 0);
            __builtin_amdgcn_sched_barrier(0); }
#pragma unroll 1
        for (int it = 0; it < 16; ++it) {
#pragma unroll
            for (int j = 0; j < 2; ++j) { u32x2 t; t.x = cvt_pk_bf16(__uint_as_float(KRr[j].x), __uint_as_float(KRr[j].y)); t.y = cvt_pk_bf16(__uint_as_float(KRr[j].z), __uint_as_float(KRr[j].w)); *(LAS u32x2*)(twk + j * 8 * 592) = t; }
#pragma unroll
            for (int q = 0; q < 16; ++q) { u32x2 t; t.x = cvt_pk_bf16(__uint_as_float(V[q].x), __uint_as_float(V[q].y)); t.y = cvt_pk_bf16(__uint_as_float(V[q].z), __uint_as_float(V[q].w)); *(LAS u32x2*)(twv + q * 592) = t; }
            __builtin_amdgcn_sched_barrier(0);
            const int itn = it < 15 ? it + 1 : 15;
            const int rown = ((itn >> 3) ? pg1 : pg0) * PAGE + (itn & 7) * 16;
#pragma unroll
            for (int j = 0; j < 2; ++j) KRr[j] = __builtin_amdgcn_raw_buffer_load_b128(rK, voP, (rown + 8 * j) * ROPE * 4, 0);
            f32x4 s = {0.f, 0.f, 0.f, 0.f};
#pragma unroll
            for (int ks = 0; ks < 9; ++ks) s = __builtin_amdgcn_mfma_f32_16x16x32_bf16(*(const LAS pg8::bf16x8*)(qfl + 64 * ks), *(const LAS pg8::bf16x8*)(tfr + 64 * ks), s, 0, 0, 0);
            __builtin_amdgcn_sched_barrier(0);
            float alpha[4];
#pragma unroll
            for (int r = 0; r < 4; ++r) {
                const float mx = row16_max(s[r]);
                const float mn = fmaxf(mrun[r], mx); alpha[r] = __builtin_amdgcn_exp2f(mrun[r] - mn); mrun[r] = mn;
                s[r] = __builtin_amdgcn_exp2f(s[r] - mn);
                const float ps = row16_sum(s[r]);
                lrun[r] = lrun[r] * alpha[r] + ps;
            }
            if (fq < 2) {
                *(LAS f32x4*)(Pw + fr * 8 + 4 * fq) = s;
                if (fr == 0) *(LAS f32x4*)(ALw + 4 * fq) = (f32x4){alpha[0], alpha[1], alpha[2], alpha[3]};
            }
            asm volatile("" ::: "memory");
            { const f32x4 a0 = *(const LAS f32x4*)ALw, a1 = *(const LAS f32x4*)(ALw + 4);
#pragma unroll
              for (int j = 0; j < 4; ++j) { acc[0][j] *= a0[0]; acc[1][j] *= a0[1]; acc[2][j] *= a0[2]; acc[3][j] *= a0[3]; acc[4][j] *= a1[0]; acc[5][j] *= a1[1]; acc[6][j] *= a1[2]; acc[7][j] *= a1[3]; } }
            __builtin_amdgcn_sched_barrier(0);
#pragma unroll
            for (int g = 0; g < 4; ++g) {
#pragma unroll
                for (int q = 4 * g; q < 4 * g + 4; ++q) { const float cx = __uint_as_float(V[q].x), cy = __uint_as_float(V[q].y), cz = __uint_as_float(V[q].z), cw_ = __uint_as_float(V[q].w);
                    const f32x4 p0 = *(const LAS f32x4*)(Pw + q * 8), p1 = *(const LAS f32x4*)(Pw + q * 8 + 4);
#pragma unroll
                    for (int hh = 0; hh < 8; ++hh) { const float ph = hh < 4 ? p0[hh] : p1[hh - 4];
                        acc[hh][0] = fmaf(ph, cx, acc[hh][0]); acc[hh][1] = fmaf(ph, cy, acc[hh][1]); acc[hh][2] = fmaf(ph, cz, acc[hh][2]); acc[hh][3] = fmaf(ph, cw_, acc[hh][3]); } }
                __builtin_amdgcn_sched_barrier(0);
#pragma unroll
                for (int q = 4 * g; q < 4 * g + 4; ++q) V[q] = __builtin_amdgcn_raw_buffer_load_b128(rC, voP, (rown + q) * KVL * 4, 0);
                __builtin_amdgcn_sched_barrier(0);
            }
            asm volatile("" ::: "memory");
        }
        const int t3 = otid(), lane3 = t3 & 63, w3 = t3 >> 6;
#pragma unroll
        for (int hh = 0; hh < 8; ++hh) *(LAS f32x4*)(CMB + w3 * (dc::WSTR / 4) + hh * 264 + 4 * lane3) = (f32x4){acc[hh][0], acc[hh][1], acc[hh][2], acc[hh][3]};
        if ((lane3 >> 4) < 2 && (lane3 & 15) == 0) {
#pragma unroll
            for (int r = 0; r < 4; ++r) { CMB[w3 * (dc::WSTR / 4) + (4 * (lane3 >> 4) + r) * 264 + 256] = mrun[r]; CMB[w3 * (dc::WSTR / 4) + (4 * (lane3 >> 4) + r) * 264 + 257] = lrun[r]; }
        }
        __syncthreads();
        {   const int lane = lane3, w = w3;
            float M = -1e30f;
#pragma unroll
            for (int ww = 0; ww < 8; ++ww) M = fmaxf(M, CMB[ww * (dc::WSTR / 4) + w * 264 + 256]);
            float L = 0.f; f32x4 o = {0.f, 0.f, 0.f, 0.f};
#pragma unroll
            for (int ww = 0; ww < 8; ++ww) { const LAS float* c = CMB + ww * (dc::WSTR / 4) + w * 264; const float f = __builtin_amdgcn_exp2f(c[256] - M); L += c[257] * f; o += *(const LAS f32x4*)(c + 4 * lane) * f; }
            float* pp = PART + ((size_t)(sb * 8 + sp) * 8 + w) * 264;
            *(f32x4*)(pp + 4 * lane) = o; if (lane == 0) { pp[256] = M; pp[257] = L; }
        }
    }
    __syncthreads();
}
NOINL void ph_gdn_out(int l);
NOINL void ph_decode_combine(int l) {
    using namespace K;
    const int tid = otid(), lane = tid & 63, w = __builtin_amdgcn_readfirstlane(tid >> 6);
    LAS float* red = (LAS float*)(dyn_lds + 1024);
    const float* wukv = uni(PRM.w_ukv) + (size_t)l * KVL * 1536; const float* PART = uni(PRM.PART); const float* QLG = uni(PRM.QLG);
    const float* CKV = uni(PRM.CKV); const float* KR = uni(PRM.KR); bf16_t* CAT = uni(PRM.CAT);
    for (int wu = obid(); wu < BS * MH; wu += ogrid()) {
        const int sb = wu >> 3, h = wu & 7, row = NP + sb;
        const float* ql = QLG + ((size_t)sb * 8 + h) * 288;
        const float4 cv = *(const float4*)(CKV + (size_t)row * KVL + 4 * lane); const float4 q4 = *(const float4*)(ql + 4 * lane);
        const float qrl = lane < 32 ? ql[256 + lane] : 0.f, krl = lane < 32 ? KR[(size_t)row * ROPE + lane] : 0.f;
        float pm[8], pl[8]; float4 pa[8];
#pragma unroll
        for (int sp = 0; sp < 8; ++sp) { const float* pp = PART + ((size_t)(sb * 8 + sp) * 8 + h) * 264; pm[sp] = pp[256]; pl[sp] = pp[257]; pa[sp] = *(const float4*)(pp + 4 * lane); }
        float wv0[32], wv1[32];
#pragma unroll
        for (int cc = 0; cc < 8; ++cc)
#pragma unroll
            for (int j = 0; j < 4; ++j) { const float* wr = wukv + (size_t)(4 * (8 * w + cc) + j) * 1536 + h * 192 + 64; wv0[4 * cc + j] = wr[lane]; wv1[4 * cc + j] = wr[lane + 64]; }
        __builtin_amdgcn_sched_barrier(0);
        if (wu == obid()) ph_gdn_out(l);
        __builtin_amdgcn_sched_barrier(0);
        float t = q4.x * cv.x + q4.y * cv.y + q4.z * cv.z + q4.w * cv.w + qrl * krl;
        const float sself = wave_sum(t, lane);
        float M = sself;
#pragma unroll
        for (int sp = 0; sp < 8; ++sp) M = fmaxf(M, pm[sp]);
        const float fs = __builtin_amdgcn_exp2f(sself - M);
        float L = fs; float o[4] = {fs * cv.x, fs * cv.y, fs * cv.z, fs * cv.w};
#pragma unroll
        for (int sp = 0; sp < 8; ++sp) { const float f = __builtin_amdgcn_exp2f(pm[sp] - M); L += pl[sp] * f;
            o[0] = fmaf(pa[sp].x, f, o[0]); o[1] = fmaf(pa[sp].y, f, o[1]); o[2] = fmaf(pa[sp].z, f, o[2]); o[3] = fmaf(pa[sp].w, f, o[3]); }
        const float il = 1.0f / L;
#pragma unroll
        for (int j = 0; j < 4; ++j) o[j] *= il;
        float o0 = 0.f, o1 = 0.f;
#pragma unroll
        for (int cc = 0; cc < 8; ++cc)
#pragma unroll
            for (int j = 0; j < 4; ++j) { const float ol = __int_as_float(__builtin_amdgcn_readlane(__float_as_int(o[j]), 8 * w + cc)); o0 = fmaf(ol, wv0[4 * cc + j], o0); o1 = fmaf(ol, wv1[4 * cc + j], o1); }
        __syncthreads();
        red[w * 128 + lane] = o0; red[w * 128 + 64 + lane] = o1;
        __syncthreads();
        if (w == 0) { float s0 = 0.f, s1 = 0.f;
#pragma unroll
            for (int ww = 0; ww < 8; ++ww) { s0 += red[ww * 128 + lane]; s1 += red[ww * 128 + 64 + lane]; }
            bf16_t* op = CAT + (size_t)row * CATW + CAT_MLA + h * 128;
            op[lane] = f2bf(s0); op[lane + 64] = f2bf(s1); }
    }
}
NOINL void ph_seq(int l) {
    using namespace K;
    constexpr int BIG = 1 << 30;
    { const int bid = obid(), grid = ogrid();
      ph_gdn_seq(l, bid, grid);
      ph_gdn_sample(l, (bid + grid - 64) % grid, grid);
      if (bid >= 64 && bid < 96) ph_rg_sample(l, bid - 64, 32);
      ph_rg_prompt(l, bid >= 160 ? bid - 160 : (1 << 30), 96); }
    constexpr unsigned DEC_CAP = 96;
    LAS int* slot = (LAS int*)(dyn_lds + 32);
    unsigned* cdec = uni(PRM.bar) + 3520 + 128 * l; unsigned* cact = cdec + 32; unsigned* catt = cdec + 64;
#pragma unroll 1
    for (int round = 0; round < 2; ++round) {
        for (;;) {
            __syncthreads();
            if (otid() == 0) {
                int q = BIG;
                const unsigned act = __hip_atomic_fetch_add(cact, 1u, __ATOMIC_RELAXED, __HIP_MEMORY_SCOPE_AGENT);
                if (act < DEC_CAP || round > 0) q = (int)__hip_atomic_fetch_add(cdec, 1u, __ATOMIC_RELAXED, __HIP_MEMORY_SCOPE_AGENT);
                if (q >= BS * 8) __hip_atomic_fetch_sub(cact, 1u, __ATOMIC_RELAXED, __HIP_MEMORY_SCOPE_AGENT);
                *slot = q;
            }
            __syncthreads();
            const int q = __builtin_amdgcn_readfirstlane(*slot);
            if (q >= BS * 8) break;
            ph_attn_sample(l, q, BIG);
            if (otid() == 0) __hip_atomic_fetch_sub(cact, 1u, __ATOMIC_RELAXED, __HIP_MEMORY_SCOPE_AGENT);
        }
        {   const bf16_t* Qb = uni(PRM.Qb); const bf16_t* Kb = uni(PRM.Kb); const bf16_t* Vt = uni(PRM.Vt); bf16_t* CAT = uni(PRM.CAT);
            for (;;) {
                __syncthreads();
                if (otid() == 0) *slot = (int)__hip_atomic_fetch_add(catt, 1u, __ATOMIC_RELAXED, __HIP_MEMORY_SCOPE_AGENT);
                __syncthreads();
                const int u = __builtin_amdgcn_readfirstlane(*slot);
                if (u >= BP * MH * 8) break;
                const int bh = u & 63;
                attn_prompt_block(Qb, Kb, Vt, CAT, bh >> 3, bh & 7, 7 - (u >> 6), otid());
            } }
    }
    __syncthreads();
}
NOINL void ph_gdn_out(int l) {
    using namespace K; GIDS
    const float* ng = uni(PRM.gdn_norm_g) + (size_t)l * GDV; const float* OG = uni(PRM.OG); const bf16_t* SZ = uni(PRM.SZ); bf16_t* CAT = uni(PRM.CAT);
    const size_t nit = (size_t)R * 128;
    const int c0 = (int)(gtid & 127) * 8;
    const float4 g0 = *(const float4*)(ng + (c0 & 127)), g1 = *(const float4*)(ng + (c0 & 127) + 4);
    const float gg[8] = {g0.x, g0.y, g0.z, g0.w, g1.x, g1.y, g1.z, g1.w};
    u32x4 on_[2]; u32x4 zn[2];
    auto ldi = [&](size_t it0) {
#pragma unroll
        for (int k = 0; k < 2; ++k) { const size_t it = it0 + k * gthreads; const size_t itc = it < nit ? it : gtid; const int row = (int)(itc >> 7);
            on_[k] = *(const u32x4*)((const bf16_t*)OG + (size_t)row * GVW + c0); zn[k] = *(const u32x4*)(SZ + (size_t)row * D + c0); } };
    if (gtid < nit) ldi(gtid);
    for (size_t it0 = gtid; it0 < nit; it0 += 2 * gthreads) {
        u32x4 ow[2]; u32x4 zw[2];
#pragma unroll
        for (int k = 0; k < 2; ++k) { ow[k] = on_[k]; zw[k] = zn[k]; }
        if (it0 + 2 * gthreads < nit) ldi(it0 + 2 * gthreads);
        __builtin_amdgcn_sched_barrier(0);
#pragma unroll
        for (int k = 0; k < 2; ++k) { const size_t it = it0 + k * gthreads; const bool on = it < nit; const int row = (int)((on ? it : it0) >> 7);
            const float o[8] = {__uint_as_float(ow[k].x << 16), __uint_as_float(ow[k].x & 0xffff0000u), __uint_as_float(ow[k].y << 16), __uint_as_float(ow[k].y & 0xffff0000u),
                                __uint_as_float(ow[k].z << 16), __uint_as_float(ow[k].z & 0xffff0000u), __uint_as_float(ow[k].w << 16), __uint_as_float(ow[k].w & 0xffff0000u)}; float ss = 0.f;
#pragma unroll
            for (int e = 0; e < 8; ++e) ss += o[e] * o[e];
            ss = row16_sum(ss);
            const float rs = rsqrtf(ss * (1.0f / GDV) + EPS);
            const float z[8] = {__uint_as_float(zw[k].x << 16), __uint_as_float(zw[k].x & 0xffff0000u), __uint_as_float(zw[k].y << 16), __uint_as_float(zw[k].y & 0xffff0000u),
                                __uint_as_float(zw[k].z << 16), __uint_as_float(zw[k].z & 0xffff0000u), __uint_as_float(zw[k].w << 16), __uint_as_float(zw[k].w & 0xffff0000u)};
            float zs[8];
#pragma unroll
            for (int e = 0; e < 8; ++e) zs[e] = z[e] * fast_sigmoid(z[e]);
            u32x4 w; w.x = cvt_pk_bf16(o[0] * rs * gg[0] * zs[0], o[1] * rs * gg[1] * zs[1]); w.y = cvt_pk_bf16(o[2] * rs * gg[2] * zs[2], o[3] * rs * gg[3] * zs[3]);
            w.z = cvt_pk_bf16(o[4] * rs * gg[4] * zs[4], o[5] * rs * gg[5] * zs[5]); w.w = cvt_pk_bf16(o[6] * rs * gg[6] * zs[6], o[7] * rs * gg[7] * zs[7]);
            if (on) *(u32x4*)(CAT + (size_t)row * CATW + CAT_GDN + c0) = w; }
    }
}
NOINL void ph_gemm_proj(int l) {
    using namespace K;
    const EpiProj E{CAT_GDN / 64, CAT_MLA / 64, uni(PRM.R1), uni(PRM.R2), uni(PRM.R3), uni(PRM.Mb)}; const bf16_t* W = uni(PRM.WPR) + (size_t)l * WPR_SZ; const bf16_t* A = uni(PRM.CAT);
    pg8::StaticOrder S; S.init(NP, D, ogrid(), obid());
    pg8::gemm_phase(GEMM_LDS, A, CATW, W, CATW, S, E);
    pg8::gemm_skinny<8>(A + (size_t)NP * CATW, CATW, W, D, CATW, NP, 0, E);
}
NOINL void ph_gemm_res(int l, int which) {
    using namespace K;
    const float* cur = l == 0 ? uni(PRM.x_prompt) : uni(PRM.X2); const float* curs = l == 0 ? uni(PRM.x_sample) - (size_t)NP * D : cur; float* mid = uni(PRM.X1); float* nxt = l == 0 ? uni(PRM.X2) : uni(PRM.X0);
    const float* modl = uni(PRM.mod) + (size_t)l * NC * 6 * D;
    const bf16_t* A = which == 0 ? uni(PRM.Mb) : uni(PRM.ACT); const int Kd = which == 0 ? D : DFF;
    const bf16_t* W = which == 0 ? uni(PRM.WO) + (size_t)l * WO_SZ : uni(PRM.WFO) + (size_t)l * WFO_SZ;
    const EpiRes E{which == 0 ? cur : mid, which == 0 ? curs : mid, which == 0 ? mid : nxt, modl + (which == 0 ? 2 * D : 5 * D), (which == 1 || l > 0) ? 1 : 0, 1};
    pg8::StaticOrder S; S.init(NP, D, ogrid(), obid());
    pg8::gemm_phase(GEMM_LDS, A, Kd, W, Kd, S, E);
    pg8::gemm_skinny<8>(A + (size_t)NP * Kd, Kd, W, D, Kd, NP, 0, E);
}
NOINL void ph_gemm_ffn_in(int l) {
    using namespace K;
    const EpiFfnIn E{uni(PRM.ACT)}; const bf16_t* W = uni(PRM.WFI) + (size_t)l * WFI_SZ; const bf16_t* A = uni(PRM.HA);
    pg8::StaticOrder S; S.init(NP, 2 * DFF, ogrid(), obid());
    pg8::gemm_phase(GEMM_LDS, A, D, W, D, S, E);
    pg8::gemm_skinny<8>(A + (size_t)NP * D, D, W, 2 * DFF, D, NP, 128, E, 128);
}
NOINL void ph_final() {
    using namespace K; GIDS
    const float* xf = uni(PRM.X0); const float* gf = uni(PRM.g_final); float* out = uni(PRM.out);
    float4 gf4[4];
#pragma unroll
    for (int i = 0; i < 4; ++i) gf4[i] = *(const float4*)(gf + i * 256 + lane * 4);
    for (int rowA = gwave; rowA < R; rowA += 2 * gwaves) {
        float4 xv[2][4];
        u32x2 xw[2][4];
#pragma unroll
        for (int k = 0; k < 2; ++k) { const int row = rowA + k * gwaves < R ? rowA + k * gwaves : rowA; const bf16_t* xr = (const bf16_t*)xf + (size_t)row * D;
#pragma unroll
            for (int i = 0; i < 4; ++i) xw[k][i] = *(const u32x2*)(xr + i * 256 + lane * 4); }
        __builtin_amdgcn_sched_barrier(0);
#pragma unroll
        for (int k = 0; k < 2; ++k)
#pragma unroll
            for (int i = 0; i < 4; ++i) xv[k][i] = make_float4(__uint_as_float(xw[k][i].x << 16), __uint_as_float(xw[k][i].x & 0xffff0000u), __uint_as_float(xw[k][i].y << 16), __uint_as_float(xw[k][i].y & 0xffff0000u));
#pragma unroll
        for (int k = 0; k < 2; ++k) { const int row = rowA + k * gwaves; if (row < R) {
            float ss = 0.f;
#pragma unroll
            for (int i = 0; i < 4; ++i) { const float4 t = xv[k][i]; ss += t.x * t.x + t.y * t.y + t.z * t.z + t.w * t.w; }
            ss = wave_sum(ss, lane); const float rs = rsqrtf(ss * (1.0f / D) + EPS);
            float* yo = out + O_YP + (size_t)row * D;
#pragma unroll
            for (int i = 0; i < 4; ++i) { const int c = i * 256 + lane * 4; const float4 t = xv[k][i], g = gf4[i];
                *(float4*)(yo + c) = make_float4(t.x * rs * g.x, t.y * rs * g.y, t.z * rs * g.z, t.w * rs * g.w); } } }
    }
}

#define PRM_FIELDS(X) X(x_prompt) X(x_sample) X(cache_ckv) X(cache_krope) X(state_rg_conv) X(state_rg_h) X(state_gdn_conv) X(state_gdn_S) X(page_table) X(c_prompt) X(c_sample) \
    X(w_ada) X(b_ada) X(g_norm1) X(g_norm2) X(w_in) X(rg_conv_w) X(rg_conv_b) X(rg_wa) X(rg_ba) X(rg_wx) X(rg_bx) X(rg_lambda) X(gdn_conv_w) X(gdn_A_log) X(gdn_dt_bias) X(gdn_norm_g) \
    X(mla_q_norm_g) X(w_uq) X(mla_kv_norm_g) X(w_ukv) X(w_rg_proj) X(w_gdn_proj) X(w_mla_proj) X(w_o) X(w_ffn_in) X(w_ffn_out) X(g_final) X(out) X(bar) \
    X(csilu) X(mod) X(X0) X(X1) X(X2) X(H) X(U) X(XC) X(GR) X(GI) X(QKVC) X(GB) X(OG) X(CQ) X(CKV) X(KR) X(Q) X(KV) X(ROT) X(HA) X(CAT) X(Mb) X(ACT) X(R1) X(R2) X(R3) X(WIN) X(WPR) X(WO) X(WFI) X(WFO) X(WUQ) X(WUKV) X(WRG) X(AQ) X(AKV) X(WUQP) X(WK) X(WV) X(Qb) X(Kb) X(Vt) X(PART) X(QLG) X(SPL) X(URX) X(GY) X(UQKV) X(SZ) X(USM) X(QKb) X(G_UT) X(G_WT) X(G_QG) X(G_KDT) X(G_AQK) X(G_EGL)

__global__ void __launch_bounds__(512, 2) fwd_kernel(Params p) {
    using namespace K;
    if ((threadIdx.x & 63) == 0) ((volatile LAS unsigned char*)(dyn_lds + 1024 - 64))[(unsigned)__builtin_amdgcn_s_getreg((5 << 11) | 4) & 63u] = (unsigned char)(threadIdx.x >> 6);
    if (threadIdx.x == 0) {
        ((volatile LAS unsigned*)dyn_lds)[0] = 0u; ((volatile LAS unsigned*)dyn_lds)[1] = 0u;
        LAS Params* L = (LAS Params*)(dyn_lds + 64);
#define X(f) L->f = p.f;
        PRM_FIELDS(X)
#undef X
    }
    __syncthreads();
    XcdBarrier bar = xcd_barrier_post(p.bar, (volatile LAS unsigned*)dyn_lds);

    ph_init(); { ConvCtx cx{0, obid(), ogrid()}; ph_convert(cx, 0, 0); ph_convert(cx, 0, 1); }
    grid_sync(bar);
    ph_mod_all();
    grid_sync(bar);
    for (int l = 0; l < DEPTH; ++l) {
        ph_norm(l, 0);
        grid_sync(bar);
        ph_gemm_u(l);
        if (l == 0 && obid() >= 64) { ConvCtx cx{0, obid() - 64, ogrid() - 64}; ph_convert(cx, 1, 0); }
        grid_sync(bar);
        ph_tok_gdn(l); ph_tok_mla(l); ph_rg_state_copies(l);
        grid_sync(bar);
        ph_gemm_qkv(l); ph_gdn_prep();
        grid_sync(bar);
        ph_seq(l);
        grid_sync(bar);
        ph_decode_combine(l);
        grid_sync(bar);
        ph_gemm_proj(l);
        grid_sync(bar);
        ph_gemm_res(l, 0);
        grid_sync(bar);
        ph_norm(l, 1);
        grid_sync(bar);
        ph_gemm_ffn_in(l);
        if (l == 0 && obid() >= 128) { ConvCtx cx{0, obid() - 128, ogrid() - 128}; ph_convert(cx, 1, 1); }
        grid_sync(bar);
        ph_gemm_res(l, 1);
        grid_sync(bar);
    }
    ph_final();
}

extern "C" void kernel_launch(void* const* d_in, const int* in_sizes, int n_in, void* d_out, int out_size, void* d_ws, size_t ws_size, hipStream_t stream) {
    using namespace K;
    (void)in_sizes; (void)n_in; (void)out_size; (void)ws_size;
    Params p{};
    p.x_prompt = (const float*)d_in[0]; p.x_sample = (const float*)d_in[1]; p.cache_ckv = (const float*)d_in[2]; p.cache_krope = (const float*)d_in[3];
    p.state_rg_conv = (const float*)d_in[4]; p.state_rg_h = (const float*)d_in[5]; p.state_gdn_conv = (const float*)d_in[6]; p.state_gdn_S = (const float*)d_in[7];
    p.page_table = (const int*)d_in[8]; p.c_prompt = (const float*)d_in[9]; p.c_sample = (const float*)d_in[10];
    p.w_ada = (const float*)d_in[11]; p.b_ada = (const float*)d_in[12]; p.g_norm1 = (const float*)d_in[13]; p.g_norm2 = (const float*)d_in[14]; p.w_in = (const float*)d_in[15];
    p.rg_conv_w = (const float*)d_in[16]; p.rg_conv_b = (const float*)d_in[17]; p.rg_wa = (const float*)d_in[18]; p.rg_ba = (const float*)d_in[19];
    p.rg_wx = (const float*)d_in[20]; p.rg_bx = (const float*)d_in[21]; p.rg_lambda = (const float*)d_in[22];
    p.gdn_conv_w = (const float*)d_in[23]; p.gdn_A_log = (const float*)d_in[24]; p.gdn_dt_bias = (const float*)d_in[25]; p.gdn_norm_g = (const float*)d_in[26];
    p.mla_q_norm_g = (const float*)d_in[27]; p.w_uq = (const float*)d_in[28]; p.mla_kv_norm_g = (const float*)d_in[29]; p.w_ukv = (const float*)d_in[30];
    p.w_rg_proj = (const float*)d_in[31]; p.w_gdn_proj = (const float*)d_in[32]; p.w_mla_proj = (const float*)d_in[33]; p.w_o = (const float*)d_in[34];
    p.w_ffn_in = (const float*)d_in[35]; p.w_ffn_out = (const float*)d_in[36]; p.g_final = (const float*)d_in[37];
    p.out = (float*)d_out;
    char* w = (char*)d_ws; size_t off = 0;
    auto take = [&](size_t nfloats) { float* r = (float*)(w + off); off += ((nfloats * 4 + 255) / 256) * 256; return r; };
    p.bar = (unsigned*)take(4096);
    p.csilu = take((size_t)NC * D); p.mod = take((size_t)DEPTH * NC * 6 * D);
    p.X0 = take((size_t)R * D); p.X1 = take((size_t)R * D); p.X2 = take((size_t)R * D); p.H = nullptr;
    p.U = nullptr; p.XC = take((size_t)R * DRNN); p.GR = nullptr; p.GI = nullptr;
    p.QKVC = take((size_t)R * GC); p.GB = take((size_t)R * 16); p.OG = take((size_t)R * GVW);
    p.CQ = take((size_t)R * QL); p.CKV = take((size_t)R * KVL); p.KR = take((size_t)R * ROPE);
    p.Q = take((size_t)R * 768); p.KV = take((size_t)NP * 1536); p.ROT = take((size_t)(SEQ + 1) * 32);
    auto takeh = [&](size_t nhalf) { return (unsigned short*)take((nhalf + 1) / 2); };
    constexpr size_t RP = 16640;
    p.HA = takeh(RP * D); p.CAT = takeh(RP * CATW); p.Mb = takeh(RP * D); p.ACT = takeh(RP * DFF);
    p.R1 = takeh(RP * D); p.R2 = takeh(RP * D); p.R3 = takeh(RP * D);
    p.WIN = takeh((size_t)DEPTH * WIN_SZ); p.WPR = takeh((size_t)DEPTH * WPR_SZ); p.WO = takeh((size_t)DEPTH * WO_SZ); p.WFI = takeh((size_t)DEPTH * WFI_SZ); p.WFO = takeh((size_t)DEPTH * WFO_SZ);
    p.WUQ = takeh((size_t)DEPTH * 768 * QL); p.WUKV = takeh((size_t)DEPTH * 1536 * KVL); p.WRG = takeh((size_t)DEPTH * RGN * 256 * 128); p.AQ = takeh(RP * QL); p.AKV = takeh(RP * KVL);
    p.WUQP = takeh((size_t)DEPTH * 768 * QL); p.WK = takeh((size_t)DEPTH * 512 * KVL); p.WV = takeh((size_t)DEPTH * 1024 * KVL); p.Qb = takeh(RP * 768); p.Kb = takeh((size_t)NP * 768); p.Vt = takeh((size_t)1024 * NP);
    p.PART = take((size_t)BS * 8 * 8 * 264); p.QLG = take((size_t)BS * 8 * 288); p.SPL = take((size_t)DEPTH * DRNN);
    p.URX = takeh(RP * DRNN); p.GY = takeh(RP * DRNN); p.UQKV = takeh(RP * GC); p.SZ = takeh(RP * D); p.USM = take((size_t)R * 688);
    p.QKb = takeh((size_t)NP * GC); p.G_UT = take((size_t)2048 * 8192); p.G_WT = takeh((size_t)2048 * 8192); p.G_QG = takeh((size_t)2048 * 8192); p.G_KDT = takeh((size_t)2048 * 8192); p.G_AQK = takeh((size_t)2048 * 4096); p.G_EGL = take(2048);
    constexpr size_t kDynLds = 1024 + 131072;
    static int grid = 0;
    if (!grid) {
        (void)hipFuncSetAttribute((const void*)fwd_kernel, hipFuncAttributeMaxDynamicSharedMemorySize, (int)kDynLds);
        int dev = 0, cus = 0, per_cu = 0;
        (void)hipGetDevice(&dev);
        (void)hipDeviceGetAttribute(&cus, hipDeviceAttributeMultiprocessorCount, dev);
        (void)hipOccupancyMaxActiveBlocksPerMultiprocessor(&per_cu, fwd_kernel, 512, kDynLds);
        if (per_cu < 1) per_cu = 1;
        grid = cus > 0 ? cus : 256;
    }
    (void)hipMemsetAsync(p.bar, 0, 4096 * sizeof(unsigned), stream);
    hipLaunchKernelGGL(fwd_kernel, dim3(grid), dim3(512), kDynLds, stream, p);
}
```
